# Optimizing an MI355X kernel written in HIP

```python
import math
import jax, jax.numpy as jnp
from jax import lax
import numpy as np

D_MODEL = 1024
BATCH = 8
SEQ = 2048
DEPTH = 2

SSD_HEADS = 16
SSD_HEAD_DIM = 64
SSD_INNER = SSD_HEADS * SSD_HEAD_DIM
SSD_GROUPS = 2
SSD_STATE = 128
SSD_CONV = 4
SSD_CHUNK = 64
GDN_HEADS = 4
GDN_HEAD_DIM = 128
GDN_WIDTH = GDN_HEADS * GDN_HEAD_DIM
GDN_CONV = 4
GDN_CHUNK = 64
GLA_HEADS = 4
GLA_KEY_DIM = 64
GLA_VAL_DIM = 128
GLA_K = GLA_HEADS * GLA_KEY_DIM
GLA_V = GLA_HEADS * GLA_VAL_DIM
GLA_GATE_RANK = 16
GLA_GATE_NORMALIZER = 16.0
GLA_CHUNK = 16
FFN_DIM = 2816
FFN_CONV = 3
N_BRANCH = 3
ALPHA = (2 * DEPTH) ** 0.25
BETA = (8 * DEPTH) ** -0.25
LN_EPS = 1e-5
RMS_EPS = 1e-6
DT_MIN = 0.001
DT_MAX = 0.1

SPLITS = (
    SSD_INNER,
    SSD_INNER + 2 * SSD_GROUPS * SSD_STATE,
    SSD_HEADS,
    3 * GDN_WIDTH,
    GDN_HEADS,
    GDN_HEADS,
    GDN_WIDTH,
    2 * GLA_K + GLA_V,
    GLA_GATE_RANK,
    GLA_V,
    N_BRANCH * D_MODEL,
)
IN_DIM = int(sum(SPLITS))
SPLIT_IDX = tuple(int(i) for i in np.cumsum(SPLITS)[:-1])

kernel_name = "hybrid_ssd_gdn_gla_deepnorm"


def causal_dwconv(x, w, b=None):
    K = w.shape[0]
    T = x.shape[1]
    xp = jnp.pad(x, ((0, 0), (K - 1, 0), (0, 0)))
    y = xp[:, 0:T] * w[0]
    for k in range(1, K):
        y = y + xp[:, k:k + T] * w[k]
    if b is not None:
        y = y + b
    return y


def layer_norm(x, g, b):
    xf = x.astype(jnp.float32)
    mu = jnp.mean(xf, -1, keepdims=True)
    var = jnp.mean(jnp.square(xf - mu), -1, keepdims=True)
    return ((xf - mu) * lax.rsqrt(var + LN_EPS) * g + b).astype(x.dtype)


def rms_norm(x, w):
    return x * lax.rsqrt(jnp.mean(x * x, -1, keepdims=True) + RMS_EPS) * w


def l2norm(x):
    return x * lax.rsqrt(jnp.sum(x * x, -1, keepdims=True) + RMS_EPS)


def ssd_mixer(z, xbc, dt_raw, conv_w, conv_b, dt_bias, a_log, d_skip, norm_w):
    f32 = jnp.float32
    Bsz, T, _ = z.shape
    L = SSD_CHUNK
    nc = T // L
    G = SSD_GROUPS
    R = SSD_HEADS // G
    P = SSD_HEAD_DIM
    N = SSD_STATE
    xbc = jax.nn.silu(causal_dwconv(xbc, conv_w, conv_b)).astype(f32)
    xs, Bm, Cm = jnp.split(xbc, [SSD_INNER, SSD_INNER + G * N], axis=-1)
    xs = xs.reshape(Bsz, nc, L, G, R, P)
    Bm = Bm.reshape(Bsz, nc, L, G, N)
    Cm = Cm.reshape(Bsz, nc, L, G, N)
    dt = jax.nn.softplus(dt_raw.astype(f32) + dt_bias.astype(f32)).reshape(Bsz, nc, L, G, R)
    A = -jnp.exp(a_log.astype(f32)).reshape(G, R)
    a_cs = jnp.cumsum(dt * A, axis=2)
    causal = jnp.tril(jnp.ones((L, L), bool))[:, :, None, None]
    seg = a_cs[:, :, :, None] - a_cs[:, :, None]
    decay = jnp.exp(jnp.where(causal, seg, -jnp.inf))
    CB = jnp.einsum('bclgn,bcsgn->bclsg', Cm, Bm)
    W = CB[..., None] * decay * dt[:, :, None]
    y = jnp.einsum('bclsgr,bcsgrp->bclgrp', W, xs)
    dec_end = jnp.exp(a_cs[:, :, -1:] - a_cs)
    states = jnp.einsum('bclgn,bclgr,bclgrp->bcgrpn', Bm, dec_end * dt, xs)
    chunk_decay = jnp.exp(a_cs[:, :, -1])

    def step(S, inp):
        st, cd = inp
        return S * cd[..., None, None] + st, S

    S0 = jnp.zeros((Bsz, G, R, P, N), f32)
    _, S_prev = lax.scan(step, S0, (jnp.moveaxis(states, 1, 0), jnp.moveaxis(chunk_decay, 1, 0)))
    S_prev = jnp.moveaxis(S_prev, 0, 1)
    y = y + jnp.einsum('bclgn,bcgrpn,bclgr->bclgrp', Cm, S_prev, jnp.exp(a_cs))
    y = y + d_skip.astype(f32).reshape(G, R)[:, :, None] * xs
    y = y.reshape(Bsz, T, SSD_INNER) * jax.nn.silu(z.astype(f32))
    y = rms_norm(y.reshape(Bsz, T, G, SSD_INNER // G), 1.0).reshape(Bsz, T, SSD_INNER)
    return (y * norm_w).astype(z.dtype)


def gdn_mixer(qkv, a_raw, b_raw, gate, conv_w, a_log, dt_bias, norm_w):
    f32 = jnp.float32
    Bsz, T, _ = qkv.shape
    H, Dh, L = GDN_HEADS, GDN_HEAD_DIM, GDN_CHUNK
    nc = T // L
    qkv = jax.nn.silu(causal_dwconv(qkv, conv_w)).astype(f32)
    q, k, v = jnp.split(qkv, 3, axis=-1)

    def heads(t):
        return t.reshape(Bsz, nc, L, H, Dh).transpose(0, 1, 3, 2, 4)

    def per_head(t):
        return t.reshape(Bsz, nc, L, H).transpose(0, 1, 3, 2)

    q = l2norm(heads(q)) * (Dh ** -0.5)
    k = l2norm(heads(k))
    v = heads(v)
    beta = per_head(jax.nn.sigmoid(b_raw.astype(f32)))
    g = -jnp.exp(a_log.astype(f32)) * jax.nn.softplus(a_raw.astype(f32) + dt_bias.astype(f32))
    g_cs = jnp.cumsum(per_head(g), -1)
    incl = jnp.tril(jnp.ones((L, L), bool))
    strict = jnp.tril(jnp.ones((L, L), bool), -1)
    gamma = jnp.exp(jnp.where(incl, g_cs[..., :, None] - g_cs[..., None, :], -jnp.inf))
    kb = k * beta[..., None]
    A = jnp.where(strict, jnp.einsum('bchld,bchsd->bchls', kb, k) * gamma, 0.0)
    eye = jnp.eye(L, dtype=f32)
    Tm = lax.linalg.triangular_solve(eye + A, jnp.broadcast_to(eye, A.shape),
                                     left_side=True, lower=True)
    u = jnp.einsum('bchls,bchsd->bchld', Tm, v * beta[..., None])
    w = jnp.einsum('bchls,bchsd->bchld', Tm, kb * jnp.exp(g_cs)[..., None])
    attn = jnp.where(incl, jnp.einsum('bchld,bchsd->bchls', q, k) * gamma, 0.0)
    q_dec = q * jnp.exp(g_cs)[..., None]
    k_dec = k * jnp.exp(g_cs[..., -1:] - g_cs)[..., None]
    chunk_decay = jnp.exp(g_cs[..., -1])

    def step(S, inp):
        u_c, w_c, qd_c, kd_c, a_c, cd_c = inp
        v_new = u_c - jnp.einsum('bhld,bhdv->bhlv', w_c, S)
        o = jnp.einsum('bhld,bhdv->bhlv', qd_c, S) + jnp.einsum('bhls,bhsv->bhlv', a_c, v_new)
        S = S * cd_c[..., None, None] + jnp.einsum('bhld,bhlv->bhdv', kd_c, v_new)
        return S, o

    seq_in = tuple(jnp.moveaxis(t, 1, 0) for t in (u, w, q_dec, k_dec, attn, chunk_decay))
    _, o = lax.scan(step, jnp.zeros((Bsz, H, Dh, Dh), f32), seq_in)
    o = o.transpose(1, 0, 3, 2, 4).reshape(Bsz, T, H, Dh)
    o = rms_norm(o, norm_w.astype(f32)) * jax.nn.silu(gate.astype(f32).reshape(Bsz, T, H, Dh))
    return o.reshape(Bsz, T, GDN_WIDTH).astype(gate.dtype)


def gla_mixer(qkv, g_lr, r, gate_w2, gate_b, norm_w):
    f32 = jnp.float32
    Bsz, T, _ = qkv.shape
    H, K, V, L = GLA_HEADS, GLA_KEY_DIM, GLA_VAL_DIM, GLA_CHUNK
    nc = T // L
    q, k, v = jnp.split(qkv.astype(f32), [GLA_K, 2 * GLA_K], axis=-1)
    gk = jax.nn.log_sigmoid(g_lr.astype(f32) @ gate_w2.astype(f32) + gate_b) / GLA_GATE_NORMALIZER
    q = q.reshape(Bsz, nc, L, H, K) * (K ** -0.5)
    k = k.reshape(Bsz, nc, L, H, K)
    v = v.reshape(Bsz, nc, L, H, V)
    b_cs = jnp.cumsum(gk.reshape(Bsz, nc, L, H, K), axis=2)
    q_e = q * jnp.exp(b_cs)
    k_e = k * jnp.exp(-b_cs)
    incl = jnp.tril(jnp.ones((L, L), bool))
    A = jnp.where(incl, jnp.einsum('bclhk,bcshk->bchls', q_e, k_e), 0.0)
    o = jnp.einsum('bchls,bcshv->bclhv', A, v)
    k_d = k * jnp.exp(b_cs[:, :, -1:] - b_cs)
    states = jnp.einsum('bclhk,bclhv->bchkv', k_d, v)
    chunk_decay = jnp.exp(b_cs[:, :, -1])

    def step(S, inp):
        st, cd = inp
        return S * cd[..., None] + st, S

    _, S_prev = lax.scan(step, jnp.zeros((Bsz, H, K, V), f32),
                         (jnp.moveaxis(states, 1, 0), jnp.moveaxis(chunk_decay, 1, 0)))
    S_prev = jnp.moveaxis(S_prev, 0, 1)
    o = o + jnp.einsum('bclhk,bchkv->bclhv', q_e, S_prev)
    o = o.reshape(Bsz, T, H, V)
    o = rms_norm(o, norm_w.astype(f32)) * jax.nn.silu(r.astype(f32).reshape(Bsz, T, H, V))
    return o.reshape(Bsz, T, GLA_V).astype(r.dtype)


def conv_glu_ffn(x, w_up, conv_w, conv_b, w_down):
    h = causal_dwconv(x @ w_up, conv_w, conv_b)
    g, u = jnp.split(h, 2, axis=-1)
    return (jax.nn.silu(g) * u) @ w_down


def setup_inputs(seed: int = 0) -> dict:
    key = jax.random.key(seed)
    keys = jax.random.split(key, 32)
    counter = iter(range(32))

    def nrm(shape, scale):
        return jax.random.normal(keys[next(counter)], shape, jnp.float32) * scale

    def unif(shape, lo, hi):
        return jax.random.uniform(keys[next(counter)], shape, jnp.float32, lo, hi)

    def dt_bias(n):
        dt = jnp.exp(unif((DEPTH, n), math.log(DT_MIN), math.log(DT_MAX)))
        return dt + jnp.log(-jnp.expm1(-dt))

    Dm = D_MODEL
    ssd_conv_ch = SSD_INNER + 2 * SSD_GROUPS * SSD_STATE
    return {
        "x": nrm((BATCH, SEQ, Dm), 1.0),
        "w_in": nrm((DEPTH, Dm, IN_DIM), Dm ** -0.5),
        "ssd_conv_w": nrm((DEPTH, SSD_CONV, ssd_conv_ch), SSD_CONV ** -0.5),
        "ssd_conv_b": nrm((DEPTH, ssd_conv_ch), 0.02),
        "ssd_dt_bias": dt_bias(SSD_HEADS),
        "ssd_a_log": jnp.log(unif((DEPTH, SSD_HEADS), 1.0, 16.0)),
        "ssd_d": 1.0 + nrm((DEPTH, SSD_HEADS), 0.02),
        "ssd_norm_w": 1.0 + nrm((DEPTH, SSD_INNER), 0.02),
        "gdn_conv_w": nrm((DEPTH, GDN_CONV, 3 * GDN_WIDTH), GDN_CONV ** -0.5),
        "gdn_a_log": jnp.log(unif((DEPTH, GDN_HEADS), 1.0, 16.0)),
        "gdn_dt_bias": dt_bias(GDN_HEADS),
        "gdn_norm_w": 1.0 + nrm((DEPTH, GDN_HEAD_DIM), 0.02),
        "gla_gate_w2": nrm((DEPTH, GLA_GATE_RANK, GLA_K), GLA_GATE_RANK ** -0.5),
        "gla_gate_b": nrm((DEPTH, GLA_K), 0.1),
        "gla_norm_w": 1.0 + nrm((DEPTH, GLA_VAL_DIM), 0.02),
        "w_br_ssd": nrm((DEPTH, SSD_INNER, Dm), BETA * SSD_INNER ** -0.5),
        "w_br_gdn": nrm((DEPTH, GDN_WIDTH, Dm), BETA * GDN_WIDTH ** -0.5),
        "w_br_gla": nrm((DEPTH, GLA_V, Dm), BETA * GLA_V ** -0.5),
        "w_out": nrm((DEPTH, Dm, Dm), BETA * Dm ** -0.5),
        "ln1_g": 1.0 + nrm((DEPTH, Dm), 0.02),
        "ln1_b": nrm((DEPTH, Dm), 0.02),
        "ffn_w_up": nrm((DEPTH, Dm, 2 * FFN_DIM), Dm ** -0.5),
        "ffn_conv_w": nrm((DEPTH, FFN_CONV, 2 * FFN_DIM), FFN_CONV ** -0.5),
        "ffn_conv_b": nrm((DEPTH, 2 * FFN_DIM), 0.02),
        "ffn_w_down": nrm((DEPTH, FFN_DIM, Dm), BETA * FFN_DIM ** -0.5),
        "ln2_g": 1.0 + nrm((DEPTH, Dm), 0.02),
        "ln2_b": nrm((DEPTH, Dm), 0.02),
    }


def reference(x, w_in, ssd_conv_w, ssd_conv_b, ssd_dt_bias, ssd_a_log, ssd_d, ssd_norm_w,
              gdn_conv_w, gdn_a_log, gdn_dt_bias, gdn_norm_w, gla_gate_w2, gla_gate_b, gla_norm_w,
              w_br_ssd, w_br_gdn, w_br_gla, w_out, ln1_g, ln1_b,
              ffn_w_up, ffn_conv_w, ffn_conv_b, ffn_w_down, ln2_g, ln2_b):
    Bsz, T, Dm = x.shape
    for l in range(DEPTH):
        h = x @ w_in[l]
        (z, xbc, dt_raw, gdn_qkv, gdn_a, gdn_b, gdn_g,
         gla_qkv, gla_glr, gla_r, gate_logits) = jnp.split(h, SPLIT_IDX, axis=-1)
        y_ssd = ssd_mixer(z, xbc, dt_raw, ssd_conv_w[l], ssd_conv_b[l], ssd_dt_bias[l],
                          ssd_a_log[l], ssd_d[l], ssd_norm_w[l]) @ w_br_ssd[l]
        y_gdn = gdn_mixer(gdn_qkv, gdn_a, gdn_b, gdn_g, gdn_conv_w[l], gdn_a_log[l],
                          gdn_dt_bias[l], gdn_norm_w[l]) @ w_br_gdn[l]
        y_gla = gla_mixer(gla_qkv, gla_glr, gla_r, gla_gate_w2[l], gla_gate_b[l],
                          gla_norm_w[l]) @ w_br_gla[l]
        gates = jax.nn.sigmoid(gate_logits).reshape(Bsz, T, N_BRANCH, Dm)
        mix = gates[:, :, 0] * y_ssd + gates[:, :, 1] * y_gdn + gates[:, :, 2] * y_gla
        x = layer_norm(ALPHA * x + mix @ w_out[l], ln1_g[l], ln1_b[l])
        x = layer_norm(ALPHA * x + conv_glu_ffn(x, ffn_w_up[l], ffn_conv_w[l], ffn_conv_b[l],
                                                ffn_w_down[l]), ln2_g[l], ln2_b[l])
    return x
```

```cpp
#include <hip/hip_runtime.h>
#include <hip/hip_cooperative_groups.h>
#include <cstdio>
namespace cg = cooperative_groups;
__device__ __forceinline__ int tid_() { int t = threadIdx.x; asm volatile("" : "+v"(t)); return t; }

namespace pg8 {
#define PG8_LAS __attribute__((address_space(3)))
typedef unsigned short bf16_t;
typedef short bf16x8 __attribute__((ext_vector_type(8)));
typedef float f32x4 __attribute__((ext_vector_type(4)));
typedef unsigned u32x4 __attribute__((ext_vector_type(4)));
constexpr int BM = 256, BK = 64, HALF = 128, HTB = HALF * BK * 2  , STAGE_BYTES = 8 * HTB, NXCD = 8, WGM = 8;

__host__ __device__ __forceinline__ int lds_byte(int r, int c) { const int st = (r >> 4) * 2 + (c >> 5), rr = r & 15, cc = c & 31, ob = rr * 64 + cc * 2; return st * 1024 + (ob ^ (((ob >> 9) & 1) << 5)); }
__host__ __device__ __forceinline__ void stage_rc(int b, int& R, int& C) { const int st = b / 1024, sb = b % 1024, swz = sb ^ (((sb >> 9) & 1) << 5); R = (st >> 1) * 16 + swz / 64; C = (st & 1) * 32 + (swz % 64) / 2; }
__host__ __device__ __forceinline__ int perm32(int rho) { const int n = rho >> 4, i = rho & 15; return 8 * (i >> 2) + 4 * n + (i & 3); }

struct Unit { int pm, pn; };
struct Gemm { const bf16_t* A; const bf16_t* Bt; int M, N, K, lda, ldb; };

struct StaticOrder {
    int nM, nN, nwg, G, c;
    __host__ __device__ void init(int M, int N, int G_, int c_) { nM = M / BM; nN = N / BM; nwg = nM * nN; G = G_; c = c_; }
    __host__ __device__ bool next(int i, Unit& u) const {
        const long L = (long)i * G + c; if (L >= nwg) return false;
        int wgid = (int)L; { const int q = nwg / NXCD, r = nwg % NXCD, xcd = wgid % NXCD, off = wgid / NXCD; wgid = (xcd < r ? xcd * (q + 1) : r * (q + 1) + (xcd - r) * q) + off; }
        const int nig = WGM * nN, gid = wgid / nig, fm = gid * WGM, gsz = (nM - fm) < WGM ? (nM - fm) : WGM;
        u.pm = fm + ((wgid % nig) % gsz); u.pn = (wgid % nig) / gsz; return true;
    }
    __device__ __forceinline__ void a_ready(const Unit&) const {}
    __device__ __forceinline__ void done(const Unit&) const {}
};
__device__ __forceinline__ unsigned cvt_pk_bf16(float lo, float hi) { unsigned r; asm volatile("v_cvt_pk_bf16_f32 %0, %1, %2" : "=v"(r) : "v"(lo), "v"(hi)); return r; }
typedef float f32x2 __attribute__((ext_vector_type(2)));
template <class Epi, class Sched, bool STAMP = false>
__device__ __forceinline__ void gemm_phase(PG8_LAS unsigned char* lds, const Gemm g, const Sched& S, const Epi& E, unsigned long long* stamps) {
    const int tid = tid_(), wid = __builtin_amdgcn_readfirstlane(tid >> 6), lane = tid & 63, wr = wid >> 2, wc = wid & 3, fr = lane & 15, fq = lane >> 4;
    const int K = g.K, nt = K / BK;
    int ts_lo = 0, ts_hi = 0, nts = 0; const unsigned long long rt_entry = STAMP ? (unsigned long long)wall_clock64() : 0ull;
#define PG8_STAMP() do { if (STAMP && wid == 0 && nts < 64) { const unsigned long long _c = (unsigned long long)clock64(); \
        ts_lo = (lane == nts) ? (int)(unsigned)_c : ts_lo; ts_hi = (lane == nts) ? (int)(unsigned)(_c >> 32) : ts_hi; ++nts; } } while (0)
    PG8_STAMP();
    unsigned voffA[2], voffB[2];
#pragma unroll
    for (int i = 0; i < 2; ++i) { int R, C; stage_rc(tid * 16 + i * 8192, R, C); const int Rb = Epi::PERM ? ((R & ~31) + perm32(R & 31)) : R;
        voffA[i] = (unsigned)(R * g.lda + C) * 2u; voffB[i] = (unsigned)(Rb * g.ldb + C) * 2u; }
    const size_t kstep = (size_t)(BK * 2);
    const size_t hstepA = (size_t)HALF * g.lda * 2, hstepB = (size_t)HALF * g.ldb * 2;
    const size_t tstepA = 2 * hstepA, tstepB = 2 * hstepB;
    const unsigned ldsw = (unsigned)wid * 1024u;
    const int aoff = lds_byte(wr * 64 + fr, fq * 8), boff = lds_byte(wc * 32 + fr, fq * 8);
#define PG8_SA(b, h) (((b) * 2 + (h)) * HTB)
#define PG8_SB(b, h) ((4 + (b) * 2 + (h)) * HTB)
#define PG8_STAGE(bufoff, gbase, voff) do { _Pragma("unroll") for (int _i = 0; _i < 2; ++_i) \
        __builtin_amdgcn_global_load_lds((const unsigned*)((const char*)(gbase) + (voff)[_i]), (PG8_LAS unsigned*)(lds + (bufoff) + ldsw + _i * 8192), 16, 0, 0); } while (0)
#define PG8_LDA(dst, b, h) do { _Pragma("unroll") for (int m = 0; m < 4; ++m) _Pragma("unroll") for (int k = 0; k < 2; ++k) dst[m][k] = *(const PG8_LAS bf16x8*)(lds + PG8_SA(b, h) + aoff + m * 2048 + k * 1024); } while (0)
#define PG8_LDB(dst, b, h) do { _Pragma("unroll") for (int n = 0; n < 2; ++n) _Pragma("unroll") for (int k = 0; k < 2; ++k) dst[n][k] = *(const PG8_LAS bf16x8*)(lds + PG8_SB(b, h) + boff + n * 2048 + k * 1024); } while (0)
#define PG8_MMA(ai, bj, At, Bt) do { __builtin_amdgcn_s_setprio(1); _Pragma("unroll") for (int m = 0; m < 4; ++m) _Pragma("unroll") for (int n = 0; n < 2; ++n) _Pragma("unroll") for (int k = 0; k < 2; ++k) \
        acc[ai][bj][m][n] = __builtin_amdgcn_mfma_f32_16x16x32_bf16(Bt[n][k], At[m][k], acc[ai][bj][m][n], 0, 0, 0); __builtin_amdgcn_s_setprio(0); } while (0)
#define PG8_WAIT_V(n) asm volatile("s_waitcnt vmcnt(" #n ")" ::: "memory")
#define PG8_WAIT_L(n) asm volatile("s_waitcnt lgkmcnt(" #n ")" ::: "memory")
#define PG8_BAR __builtin_amdgcn_s_barrier()
#define PG8_SCHED __builtin_amdgcn_sched_barrier(0)
    Unit cur, nxt; int ui = 0;
    if (!S.next(0, cur)) return;
    f32x4 acc[2][2][4][2];
#pragma unroll
    for (int a = 0; a < 2; ++a)
#pragma unroll
        for (int b = 0; b < 2; ++b)
#pragma unroll
            for (int m = 0; m < 4; ++m)
#pragma unroll
                for (int n = 0; n < 2; ++n) acc[a][b][m][n] = (f32x4){0.f, 0.f, 0.f, 0.f};
    bf16x8 At[4][2], B0[2][2], B1[2][2];
    const char* cA = (const char*)g.A + (size_t)cur.pm * tstepA; const char* cB = (const char*)g.Bt + (size_t)cur.pn * tstepB;
    S.a_ready(cur);
    PG8_STAGE(PG8_SB(0, 0), cB, voffB); PG8_STAGE(PG8_SA(0, 0), cA, voffA); PG8_STAGE(PG8_SB(0, 1), cB + hstepB, voffB); PG8_STAGE(PG8_SA(0, 1), cA + hstepA, voffA);
    if (wr == 1) PG8_BAR;
    PG8_WAIT_V(4); PG8_BAR;
    PG8_STAGE(PG8_SB(1, 0), cB + kstep, voffB); PG8_STAGE(PG8_SA(1, 0), cA + kstep, voffA); PG8_STAGE(PG8_SB(1, 1), cB + hstepB + kstep, voffB);
    PG8_WAIT_V(6); PG8_BAR;
    PG8_STAMP();
    for (;;) {
        const bool has_next = S.next(ui + 1, nxt);
        const char* nA = has_next ? (const char*)g.A + (size_t)nxt.pm * tstepA : cA; const char* nB = has_next ? (const char*)g.Bt + (size_t)nxt.pn * tstepB : cB;
        for (int t = 0; t < nt; t += 2) {
            const bool last = (t == nt - 2);
            const char* a1 = cA + (size_t)(t + 1) * kstep;
            const char* a2 = last ? nA : cA + (size_t)(t + 2) * kstep; const char* b2 = last ? nB : cB + (size_t)(t + 2) * kstep;
            const char* a3 = a2 + kstep; const char* b3 = b2 + kstep;
            if (last && has_next) S.a_ready(nxt);
            PG8_LDB(B0, 0, 0); PG8_SCHED; PG8_LDA(At, 0, 0); PG8_STAGE(PG8_SA(1, 1), a1 + hstepA, voffA);
            PG8_WAIT_L(8); PG8_BAR; PG8_WAIT_L(0); PG8_MMA(0, 0, At, B0); PG8_BAR; PG8_SCHED;
            PG8_LDB(B1, 0, 1); PG8_STAGE(PG8_SB(0, 0), b2, voffB);
            PG8_BAR; PG8_WAIT_L(0); PG8_MMA(0, 1, At, B1); PG8_BAR;
            PG8_LDA(At, 0, 1); PG8_STAGE(PG8_SA(0, 0), a2, voffA);
            PG8_BAR; PG8_WAIT_L(0); PG8_MMA(1, 0, At, B0); PG8_BAR; PG8_SCHED;
            PG8_STAGE(PG8_SB(0, 1), b2 + hstepB, voffB);
            PG8_WAIT_V(6); PG8_BAR; PG8_MMA(1, 1, At, B1); PG8_BAR;
            PG8_LDB(B0, 1, 0); PG8_SCHED; PG8_LDA(At, 1, 0); PG8_STAGE(PG8_SA(0, 1), a2 + hstepA, voffA);
            PG8_WAIT_L(8); PG8_BAR; PG8_WAIT_L(0); PG8_MMA(0, 0, At, B0); PG8_BAR; PG8_SCHED;
            PG8_LDB(B1, 1, 1); PG8_STAGE(PG8_SB(1, 0), b3, voffB);
            PG8_BAR; PG8_WAIT_L(0); PG8_MMA(0, 1, At, B1); PG8_BAR;
            PG8_LDA(At, 1, 1); PG8_STAGE(PG8_SA(1, 0), a3, voffA);
            PG8_BAR; PG8_WAIT_L(0); PG8_MMA(1, 0, At, B0); PG8_BAR; PG8_SCHED;
            PG8_STAGE(PG8_SB(1, 1), b3 + hstepB, voffB);
            PG8_WAIT_V(6); PG8_BAR; PG8_MMA(1, 1, At, B1); PG8_BAR;
        }
        PG8_STAMP();
        if constexpr (!Epi::AFTER_DRAIN) { E(acc, cur, wr, wc, fr, fq); S.done(cur); }
        PG8_STAMP();
        if (!has_next) break;
#pragma unroll
        for (int a = 0; a < 2; ++a)
#pragma unroll
            for (int b = 0; b < 2; ++b)
#pragma unroll
                for (int m = 0; m < 4; ++m)
#pragma unroll
                    for (int n = 0; n < 2; ++n) acc[a][b][m][n] = (f32x4){0.f, 0.f, 0.f, 0.f};
        cur = nxt; cA = nA; cB = nB; ++ui;
    }
    PG8_WAIT_V(0);
    if (wr == 0) PG8_BAR;
    PG8_BAR;
    if constexpr (Epi::AFTER_DRAIN) { E.fused(acc, cur, wr, wc, fr, fq, lds, wid, lane); S.done(cur); }
    PG8_STAMP();
    if (STAMP && wid == 0) { stamps[lane] = lane < nts ? (((unsigned long long)(unsigned)ts_hi << 32) | (unsigned)ts_lo) : 0ull;
        if (lane == 62) stamps[62] = rt_entry; if (lane == 63) stamps[63] = (unsigned long long)wall_clock64(); }
#undef PG8_STAMP
#undef PG8_SA
#undef PG8_SB
#undef PG8_STAGE
#undef PG8_LDA
#undef PG8_LDB
#undef PG8_MMA
#undef PG8_WAIT_V
#undef PG8_WAIT_L
#undef PG8_BAR
#undef PG8_SCHED
}
}

using pg8::bf16_t; using pg8::bf16x8; using pg8::f32x4; using pg8::u32x4;
#define LAS __attribute__((address_space(3)))
constexpr int DM = 1024, NB = 8, SEQ = 2048, MTOK = NB * SEQ, DEPTH = 2, IN_DIM = 9256;
constexpr int HP = 6144;
constexpr int C_Z = 0, C_XBC = 1024, C_GQKV = 2560, C_GG = 4096, C_LQKV = 4608, C_LR = 5632;
constexpr int O_Z = 0, O_XBC = 1024, O_DT = 2560, O_GQKV = 2576, O_GA = 4112, O_GB = 4116, O_GG = 4120, O_LQKV = 4632, O_GLR = 5656, O_LR = 5672, O_GATES = 6184;
constexpr int HS = 64;
constexpr int FF = 2816, FF2 = 5632;
constexpr float ALPHA = 1.41421356237f, LN_EPS = 1e-5f, RMS_EPS = 1e-6f;
constexpr int LDS_BYTES = 160 * 1024;
constexpr size_t W_W1 = 0, W_SM = W_W1 + (size_t)6144 * 1024 * 2, W_G = W_SM + (size_t)64 * 1024 * 2, W_PS = W_G + (size_t)3072 * 1024 * 2, W_PG = W_PS + (size_t)1024 * 1024 * 2,
                 W_PL = W_PG + (size_t)1024 * 512 * 2, W_O = W_PL + (size_t)1024 * 512 * 2, W_UP = W_O + (size_t)1024 * 1024 * 2, W_DN = W_UP + (size_t)5632 * 1024 * 2,
                 WS_XB = W_DN + (size_t)1024 * 2816 * 2, WS_HS = WS_XB + (size_t)MTOK * 1024 * 2, WS_BIG = WS_HS + (size_t)MTOK * HS * 4, WS_END = WS_BIG + (size_t)MTOK * HP * 2;

struct Params { const float* in[27]; float* out; unsigned char* ws; };

__device__ __forceinline__ float bf2f(bf16_t v) { return __uint_as_float(((unsigned)v) << 16); }
__device__ __forceinline__ bf16_t f2bf(float f) { unsigned u = __float_as_uint(f); u += 0x7FFFu + ((u >> 16) & 1u); return (bf16_t)(u >> 16); }
__device__ __forceinline__ unsigned pk2(float lo, float hi) { return (unsigned)f2bf(lo) | ((unsigned)f2bf(hi) << 16); }
__device__ __forceinline__ float sigmoidf_(float x) { return 1.0f / (1.0f + __expf(-x)); }
__device__ __forceinline__ float siluf_(float x) { return x / (1.0f + __expf(-x)); }
__device__ __forceinline__ float softplusf_(float x) { return x > 20.f ? x : log1pf(__expf(x)); }
__device__ __forceinline__ void unpack8(const u32x4 w, float (&f)[8]) {
    f[0] = __uint_as_float(w.x << 16); f[1] = __uint_as_float(w.x & 0xffff0000u); f[2] = __uint_as_float(w.y << 16); f[3] = __uint_as_float(w.y & 0xffff0000u);
    f[4] = __uint_as_float(w.z << 16); f[5] = __uint_as_float(w.z & 0xffff0000u); f[6] = __uint_as_float(w.w << 16); f[7] = __uint_as_float(w.w & 0xffff0000u); }
__device__ __forceinline__ u32x4 pack8(const float (&f)[8]) { u32x4 w; w.x = pk2(f[0], f[1]); w.y = pk2(f[2], f[3]); w.z = pk2(f[4], f[5]); w.w = pk2(f[6], f[7]); return w; }

struct EpiU {
    static constexpr bool PERM = true, AFTER_DRAIN = false;
    int mode; bf16_t* O; int ldc; const bf16_t* Sg; const float* base; float* out;
    __device__ __forceinline__ void operator()(const f32x4 (&acc)[2][2][4][2], const pg8::Unit& u, int wr, int wc, int fr, int fq) const {
        const int row0 = u.pm * 256 + wr * 64 + fr, col0 = u.pn * 256 + wc * 32 + 8 * fq;
#pragma unroll
        for (int ai = 0; ai < 2; ++ai)
#pragma unroll
            for (int m = 0; m < 4; ++m) { const int row = row0 + ai * 128 + m * 16;
#pragma unroll
                for (int bj = 0; bj < 2; ++bj) { f32x4 v0 = acc[ai][bj][m][0], v1 = acc[ai][bj][m][1];
                    if (mode == 4) { const size_t off = (size_t)row * DM + col0 + bj * 128;
                        const f32x4 b0 = *(const f32x4*)(base + off), b1 = *(const f32x4*)(base + off + 4);
                        *(f32x4*)(out + off) = b0 * ALPHA + v0; *(f32x4*)(out + off + 4) = b1 * ALPHA + v1;
                    } else { const size_t off = (size_t)row * ldc + col0 + bj * 128;
                        if (mode == 5) { v0 = (f32x4){0.f, 0.f, 0.f, 0.f}; v1 = v0; }
                        if (mode == 1) {
#pragma unroll
                            for (int j = 0; j < 4; ++j) { v0[j] = sigmoidf_(v0[j]); v1[j] = sigmoidf_(v1[j]); } }
                        if (mode >= 2) { float sg[8]; unpack8(*(const u32x4*)(Sg + off), sg);
#pragma unroll
                            for (int j = 0; j < 4; ++j) { v0[j] *= sg[j]; v1[j] *= sg[4 + j]; }
                            if (mode == 3) { float o[8]; unpack8(*(const u32x4*)(O + off), o);
#pragma unroll
                                for (int j = 0; j < 4; ++j) { v0[j] += o[j]; v1[j] += o[4 + j]; } } }
                        u32x4 w; w.x = pk2(v0[0], v0[1]); w.y = pk2(v0[2], v0[3]); w.z = pk2(v1[0], v1[1]); w.w = pk2(v1[2], v1[3]);
                        *(u32x4*)(O + off) = w; } }
                asm volatile("" ::: "memory"); }
    }
};
struct GJob { const bf16_t* A; int lda; const bf16_t* Bt; int ldb; int N, K; EpiU E; };
__device__ __forceinline__ void run_gemm(LAS unsigned char* lds, const GJob& j) {
    pg8::Gemm g; g.A = j.A; g.Bt = j.Bt; g.M = MTOK; g.N = j.N; g.K = j.K; g.lda = j.lda; g.ldb = j.ldb;
    pg8::StaticOrder S; S.init(MTOK, j.N, (int)gridDim.x, (int)blockIdx.x);
    pg8::gemm_phase<EpiU, pg8::StaticOrder, false>(lds, g, S, j.E, nullptr);
}
__device__ __forceinline__ void tr_item(const float* W, int ldw, int col0, int K, int ncols, bf16_t* WT, int row_off, LAS float* scr, int item, int lane) {
    const int nblk = ncols / 32, kb = item / nblk, nb = item % nblk, k0 = 64 * kb, n0 = 32 * nb;
#pragma unroll 8
    for (int i = 0; i < 32; ++i) { const int kk = 2 * i + (lane >> 5); scr[kk * 33 + (lane & 31)] = W[(size_t)(k0 + kk) * ldw + col0 + n0 + (lane & 31)]; }
    asm volatile("s_waitcnt lgkmcnt(0)" ::: "memory");
    const int c = lane & 7;
#pragma unroll
    for (int j = 0; j < 4; ++j) { const int n = (lane >> 3) + 8 * j; const LAS float* s = scr + (8 * c) * 33 + n;
        u32x4 o; o.x = pk2(s[0 * 33], s[1 * 33]); o.y = pk2(s[2 * 33], s[3 * 33]); o.z = pk2(s[4 * 33], s[5 * 33]); o.w = pk2(s[6 * 33], s[7 * 33]);
        *(u32x4*)(WT + (size_t)(row_off + n0 + n) * K + k0 + 8 * c) = o; }
    asm volatile("s_waitcnt lgkmcnt(0)" ::: "memory");
}
__device__ __forceinline__ void phase_convert(const Params& p, int layer, LAS unsigned char* lds) {
    const int tid = tid_(), wid = tid >> 6, lane = tid & 63;
    LAS float* scr = (LAS float*)(lds + wid * 16384);
    unsigned char* ws = p.ws;
    const float* w_in = p.in[1] + (size_t)layer * DM * IN_DIM;
    bf16_t* W1 = (bf16_t*)(ws + W_W1); bf16_t* WG = (bf16_t*)(ws + W_G);
    const int gw = blockIdx.x * 8 + wid, NGW = gridDim.x * 8;
#define JOB(src, ldw, col0, K, ncols, dst, rowoff) { const int ni = ((K) / 64) * ((ncols) / 32); if (r < ni) { tr_item(src, ldw, col0, K, ncols, dst, rowoff, scr, r, lane); continue; } r -= ni; }
    for (int it = gw; ; it += NGW) {
        int r = it;
        JOB(w_in, IN_DIM, O_Z, 1024, 1024, W1, C_Z)
        JOB(w_in, IN_DIM, O_XBC, 1024, 1536, W1, C_XBC)
        JOB(w_in, IN_DIM, O_GQKV, 1024, 1536, W1, C_GQKV)
        JOB(w_in, IN_DIM, O_GG, 1024, 512, W1, C_GG)
        JOB(w_in, IN_DIM, O_LQKV, 1024, 1024, W1, C_LQKV)
        JOB(w_in, IN_DIM, O_LR, 1024, 512, W1, C_LR)
        JOB(w_in, IN_DIM, O_GATES, 1024, 3072, WG, 0)
        JOB(p.in[15] + (size_t)layer * 1024 * 1024, 1024, 0, 1024, 1024, (bf16_t*)(ws + W_PS), 0)
        JOB(p.in[16] + (size_t)layer * 512 * 1024, 1024, 0, 512, 1024, (bf16_t*)(ws + W_PG), 0)
        JOB(p.in[17] + (size_t)layer * 512 * 1024, 1024, 0, 512, 1024, (bf16_t*)(ws + W_PL), 0)
        JOB(p.in[18] + (size_t)layer * 1024 * 1024, 1024, 0, 1024, 1024, (bf16_t*)(ws + W_O), 0)
        JOB(p.in[21] + (size_t)layer * 1024 * FF2, FF2, 0, 1024, FF2, (bf16_t*)(ws + W_UP), 0)
        JOB(p.in[24] + (size_t)layer * FF * 1024, 1024, 0, FF, 1024, (bf16_t*)(ws + W_DN), 0)
        break;
    }
#undef JOB
    bf16_t* WS = (bf16_t*)(ws + W_SM);
    for (int i = blockIdx.x * 512 + tid; i < 64 * 1024; i += gridDim.x * 512) {
        const int n = i >> 10, k = i & 1023; int oc = -1;
        if (n < 16) oc = O_DT + n; else if (n < 20) oc = O_GA + n - 16; else if (n < 24) oc = O_GB + n - 20; else if (n < 40) oc = O_GLR + n - 24;
        WS[i] = oc >= 0 ? f2bf(w_in[(size_t)k * IN_DIM + oc]) : (bf16_t)0;
    }
}
__device__ __forceinline__ void phase_x_to_bf16(const Params& p) {
    const float* x = p.in[0]; bf16_t* xb = (bf16_t*)(p.ws + WS_XB);
    for (size_t i = (size_t)blockIdx.x * 512 + tid_(); i < (size_t)MTOK * DM / 8; i += (size_t)gridDim.x * 512) {
        const f32x4 a = *(const f32x4*)(x + i * 8), b = *(const f32x4*)(x + i * 8 + 4);
        u32x4 w; w.x = pk2(a[0], a[1]); w.y = pk2(a[2], a[3]); w.z = pk2(b[0], b[1]); w.w = pk2(b[2], b[3]);
        *(u32x4*)(xb + i * 8) = w; }
}
__device__ __forceinline__ void phase_small(const Params& p) {
    const int tid = tid_(), wid = tid >> 6, lane = tid & 63, fr = lane & 15, fq = lane >> 4, mt = wid & 3, np = wid >> 2;
    const bf16_t* xb = (const bf16_t*)(p.ws + WS_XB); const bf16_t* WS = (const bf16_t*)(p.ws + W_SM); float* hs = (float*)(p.ws + WS_HS);
    for (int rb = blockIdx.x; rb < MTOK / 64; rb += gridDim.x) {
        const int r0 = rb * 64;
        f32x4 a0 = {0.f, 0.f, 0.f, 0.f}, a1 = {0.f, 0.f, 0.f, 0.f};
        const bf16_t* ap = xb + (size_t)(r0 + 16 * mt + fr) * 1024 + 8 * fq; const bf16_t* b0p = WS + (size_t)(32 * np + fr) * 1024 + 8 * fq; const bf16_t* b1p = b0p + 16 * 1024;
#pragma unroll 4
        for (int kk = 0; kk < 32; ++kk) { const bf16x8 a = *(const bf16x8*)(ap + kk * 32), b0 = *(const bf16x8*)(b0p + kk * 32), b1 = *(const bf16x8*)(b1p + kk * 32);
            a0 = __builtin_amdgcn_mfma_f32_16x16x32_bf16(a, b0, a0, 0, 0, 0); a1 = __builtin_amdgcn_mfma_f32_16x16x32_bf16(a, b1, a1, 0, 0, 0); }
#pragma unroll
        for (int j = 0; j < 4; ++j) { float* o = hs + (size_t)(r0 + 16 * mt + 4 * fq + j) * HS + 32 * np + fr; o[0] = a0[j]; o[16] = a1[j]; }
    }
}

__device__ __forceinline__ void ssd_chain(const Params& p, int layer, int idx, LAS unsigned char* lds) {
    const int tid = tid_(), b = idx >> 4, head = idx & 15, grp = head >> 3;
    bf16_t* H = (bf16_t*)(p.ws + WS_BIG) + (size_t)b * SEQ * HP; const float* hs = (const float*)(p.ws + WS_HS) + (size_t)b * SEQ * HS;
    LAS float* dts = (LAS float*)lds;
    LAS float* buf = (LAS float*)(lds + 8192);
    const float A = -__expf(p.in[5][layer * 16 + head]), Dk = p.in[6][layer * 16 + head], dtb = p.in[4][layer * 16 + head];
    for (int t = tid; t < SEQ; t += 512) dts[t] = softplusf_(hs[(size_t)t * HS + head] + dtb);
    int col = 0; float w0 = 0.f, w1 = 0.f, w2 = 0.f, w3 = 0.f, cb = 0.f;
    if (tid < 320) { const int ch = tid < 64 ? head * 64 + tid : (tid < 192 ? 1024 + grp * 128 + (tid - 64) : 1280 + grp * 128 + (tid - 192)); col = C_XBC + ch;
        const float* cw = p.in[2] + (size_t)layer * 4 * 1536; w0 = cw[ch]; w1 = cw[1536 + ch]; w2 = cw[2 * 1536 + ch]; w3 = cw[3 * 1536 + ch]; cb = p.in[3][layer * 1536 + ch]; }
    const int pp = tid >> 3, ns = tid & 7;
    float h[16];
#pragma unroll
    for (int j = 0; j < 16; ++j) h[j] = 0.f;
    float x0 = 0.f, x1 = 0.f, x2 = 0.f, cur[8], nx[8], zc[8], zn[8];
    const bf16_t* src = H + col; const bf16_t* zsrc = H + C_Z + head * 64 + pp;
    { const float xt = tid < 320 ? bf2f(src[0]) : 0.f; if (tid < 320) buf[tid] = siluf_(w3 * xt + cb); x2 = xt; }
#pragma unroll
    for (int i = 0; i < 8; ++i) { cur[i] = (tid < 320) ? bf2f(src[(size_t)(1 + i) * HP]) : 0.f; zc[i] = bf2f(zsrc[(size_t)i * HP]); }
    __syncthreads();
    for (int g = 0; g < SEQ / 8; ++g) {
#pragma unroll
        for (int i = 0; i < 8; ++i) { const int tn = 8 * (g + 1) + 1 + i; nx[i] = (tid < 320 && tn < SEQ) ? bf2f(src[(size_t)tn * HP]) : 0.f; const int tz = 8 * (g + 1) + i; zn[i] = tz < SEQ ? bf2f(zsrc[(size_t)tz * HP]) : 0.f; }
#pragma unroll
        for (int i = 0; i < 8; ++i) {
            const int t = 8 * g + i;
            if (tid < 320) { const float xt = cur[i]; buf[((t + 1) & 1) * 320 + tid] = siluf_(w0 * x0 + w1 * x1 + w2 * x2 + w3 * xt + cb); x0 = x1; x1 = x2; x2 = xt; }
            const LAS float* bb = buf + (t & 1) * 320;
            const float dt = dts[t], dA = __expf(dt * A), xv = bb[pp], dx = dt * xv; float y = 0.f;
#pragma unroll
            for (int j4 = 0; j4 < 4; ++j4) { const f32x4 Bv = *(const LAS f32x4*)(bb + 64 + 16 * ns + 4 * j4), Cv = *(const LAS f32x4*)(bb + 192 + 16 * ns + 4 * j4);
#pragma unroll
                for (int j = 0; j < 4; ++j) { h[4 * j4 + j] = dA * h[4 * j4 + j] + dx * Bv[j]; y += Cv[j] * h[4 * j4 + j]; } }
            y += __shfl_xor(y, 1); y += __shfl_xor(y, 2); y += __shfl_xor(y, 4);
            if (ns == 0) { const float o = (y + Dk * xv) * siluf_(zc[i]); H[(size_t)t * HP + C_Z + head * 64 + pp] = f2bf(o); }
            __syncthreads();
        }
#pragma unroll
        for (int i = 0; i < 8; ++i) { cur[i] = nx[i]; zc[i] = zn[i]; }
    }
}
__device__ __forceinline__ void gdn_chain(const Params& p, int layer, int idx, LAS unsigned char* lds) {
    const int tid = tid_(), b = idx >> 2, hh = idx & 3, lane = tid & 63, wid = tid >> 6;
    bf16_t* H = (bf16_t*)(p.ws + WS_BIG) + (size_t)b * SEQ * HP; const float* hs = (const float*)(p.ws + WS_HS) + (size_t)b * SEQ * HS;
    LAS float* egs = (LAS float*)lds;
    LAS float* bts = (LAS float*)(lds + 8192);
    LAS float* buf = (LAS float*)(lds + 16384);
    LAS float* ssq = (LAS float*)(lds + 16384 + 3072);
    const float An = -__expf(p.in[9][layer * 4 + hh]), dtb = p.in[10][layer * 4 + hh];
    for (int t = tid; t < SEQ; t += 512) { egs[t] = __expf(An * softplusf_(hs[(size_t)t * HS + 16 + hh] + dtb)); bts[t] = sigmoidf_(hs[(size_t)t * HS + 20 + hh]); }
    const bool prod = tid < 384, cons = tid < 256; const int pc = tid, vcol = tid >> 1, hf = tid & 1;
    float w0 = 0.f, w1 = 0.f, w2 = 0.f, w3 = 0.f; int col = 0;
    if (prod) { const int ch = (pc >> 7) * 512 + hh * 128 + (pc & 127); col = C_GQKV + ch; const float* cw = p.in[8] + (size_t)layer * 4 * 1536; w0 = cw[ch]; w1 = cw[1536 + ch]; w2 = cw[2 * 1536 + ch]; w3 = cw[3 * 1536 + ch]; }
    const bf16_t* src = H + col;
    float S[64];
#pragma unroll
    for (int j = 0; j < 64; ++j) S[j] = 0.f;
    float x0 = 0.f, x1 = 0.f, x2 = 0.f, ra = 0.f, rb = 0.f, rc = 0.f;
    if (prod) { const float xt = bf2f(src[0]); const float y = siluf_(w3 * xt); buf[pc] = y; x2 = xt; float s = y * y;
#pragma unroll
        for (int o = 1; o < 64; o <<= 1) s += __shfl_xor(s, o);
        if (lane == 0) ssq[wid] = s;
        ra = bf2f(src[(size_t)1 * HP]); rb = bf2f(src[(size_t)2 * HP]); rc = bf2f(src[(size_t)3 * HP]); }
    __syncthreads();
#pragma unroll 1
    for (int t = 0; t < SEQ; ++t) {
        float rd = 0.f;
        if (prod) { rd = (t + 4 < SEQ) ? bf2f(src[(size_t)(t + 4) * HP]) : 0.f;
            const float xt = ra; const float y = siluf_(w0 * x0 + w1 * x1 + w2 * x2 + w3 * xt); buf[((t + 1) & 1) * 384 + pc] = y; x0 = x1; x1 = x2; x2 = xt; float s = y * y;
#pragma unroll
            for (int o = 1; o < 64; o <<= 1) s += __shfl_xor(s, o);
            if (lane == 0) ssq[((t + 1) & 1) * 8 + wid] = s; }
        if (cons) {
            const LAS float* bb = buf + (t & 1) * 384; const LAS float* sq = ssq + (t & 1) * 8;
            const float qn = rsqrtf(sq[0] + sq[1] + RMS_EPS) * 0.08838834764831845f, kn = rsqrtf(sq[2] + sq[3] + RMS_EPS);
            const float eg = egs[t], bt = bts[t], vt = bb[256 + vcol];
            const LAS float* kp = bb + 128 + 64 * hf; const LAS float* qp = bb + 64 * hf;
            float u = 0.f;
#pragma unroll
            for (int d4 = 0; d4 < 16; ++d4) { const f32x4 kv = *(const LAS f32x4*)(kp + 4 * d4);
#pragma unroll
                for (int j = 0; j < 4; ++j) u += kv[j] * S[4 * d4 + j];
                if ((d4 & 3) == 3) asm volatile("" ::: "memory"); }
            u += __shfl_xor(u, 1); u *= kn;
            const float w = bt * (vt - eg * u) * kn; float o = 0.f;
#pragma unroll
            for (int d4 = 0; d4 < 16; ++d4) { const f32x4 kv = *(const LAS f32x4*)(kp + 4 * d4), qv = *(const LAS f32x4*)(qp + 4 * d4);
#pragma unroll
                for (int j = 0; j < 4; ++j) { S[4 * d4 + j] = eg * S[4 * d4 + j] + kv[j] * w; o += qv[j] * S[4 * d4 + j]; }
                if ((d4 & 3) == 3) asm volatile("" ::: "memory"); }
            o += __shfl_xor(o, 1);
            if (hf == 0) H[(size_t)t * HP + C_GQKV + hh * 128 + vcol] = f2bf(o * qn);
        }
        ra = rb; rb = rc; rc = rd;
        __syncthreads();
    }
}
__device__ __forceinline__ void gla_chain(const Params& p, int layer, int idx, LAS unsigned char* lds) {
    const int tid = tid_(), b = idx >> 2, hh = idx & 3;
    bf16_t* H = (bf16_t*)(p.ws + WS_BIG) + (size_t)b * SEQ * HP; const float* hs = (const float*)(p.ws + WS_HS) + (size_t)b * SEQ * HS;
    LAS float* buf = (LAS float*)lds;
    const int role = tid < 128 ? 0 : (tid < 192 ? 1 : (tid < 256 ? 2 : (tid < 320 ? 3 : 4)));
    const int kk = (tid - 128) & 63;
    float w2c[16], gb = 0.f;
#pragma unroll
    for (int r = 0; r < 16; ++r) w2c[r] = role == 3 ? p.in[12][(size_t)layer * 16 * 256 + r * 256 + hh * 64 + kk] : 0.f;
    if (role == 3) gb = p.in[13][layer * 256 + hh * 64 + kk];
    const bf16_t* src = H + (role == 0 ? C_LQKV + 512 + hh * 128 + tid : (role == 1 ? C_LQKV + hh * 64 + kk : C_LQKV + 256 + hh * 64 + kk));
    float S[64];
#pragma unroll
    for (int j = 0; j < 64; ++j) S[j] = 0.f;
    float cur[8], nx[8];
    auto produce = [&](int t, float raw) {
        if (role == 1) buf[(t & 1) * 192 + kk] = raw * 0.125f;
        else if (role == 2) buf[(t & 1) * 192 + 64 + kk] = raw;
        else if (role == 3) { const float* gl = hs + (size_t)t * HS + 24; float a = gb;
#pragma unroll
            for (int r = 0; r < 16; ++r) a += gl[r] * w2c[r];
            const float ls = -softplusf_(-a); buf[(t & 1) * 192 + 128 + kk] = __expf(ls * 0.0625f); }
    };
    { const float r0 = (role == 1 || role == 2) ? bf2f(src[0]) : 0.f; produce(0, r0); }
#pragma unroll
    for (int i = 0; i < 8; ++i) { const int tt = role == 0 ? i : 1 + i; cur[i] = (role <= 2 && tt < SEQ) ? bf2f(src[(size_t)tt * HP]) : 0.f; }
    __syncthreads();
    for (int g = 0; g < SEQ / 8; ++g) {
#pragma unroll
        for (int i = 0; i < 8; ++i) { const int tn = 8 * (g + 1) + i + (role == 0 ? 0 : 1); nx[i] = (role <= 2 && tn < SEQ) ? bf2f(src[(size_t)tn * HP]) : 0.f; }
#pragma unroll
        for (int i = 0; i < 8; ++i) {
            const int t = 8 * g + i;
            if (role == 0) {
                const LAS float* bb = buf + (t & 1) * 192; const float vt = cur[i]; float o = 0.f;
#pragma unroll
                for (int d4 = 0; d4 < 16; ++d4) { const f32x4 qv = *(const LAS f32x4*)(bb + 4 * d4), kv = *(const LAS f32x4*)(bb + 64 + 4 * d4), ev = *(const LAS f32x4*)(bb + 128 + 4 * d4);
#pragma unroll
                    for (int j = 0; j < 4; ++j) { S[4 * d4 + j] = ev[j] * S[4 * d4 + j] + kv[j] * vt; o += qv[j] * S[4 * d4 + j]; } }
                H[(size_t)t * HP + C_LQKV + 512 + hh * 128 + tid] = f2bf(o);
            } else if (role <= 3 && t + 1 < SEQ) produce(t + 1, cur[i]);
            __syncthreads();
        }
#pragma unroll
        for (int i = 0; i < 8; ++i) cur[i] = nx[i];
    }
}
__device__ __forceinline__ void phase_mixers(const Params& p, int layer, LAS unsigned char* lds) {
    for (int role = blockIdx.x; role < 192; role += gridDim.x) {
        __syncthreads();
#ifndef CHAIN
#define CHAIN 7
#endif
        if (role < 32) { if (CHAIN & 1) gdn_chain(p, layer, role, lds); }
        else if (role < 64) { if (CHAIN & 2) gla_chain(p, layer, role - 32, lds); }
        else { if (CHAIN & 4) ssd_chain(p, layer, role - 64, lds); }
    }
}
__device__ __forceinline__ void phase_finalize(const Params& p, int layer) {
    const int tid = tid_(), wid = tid >> 6, lane = tid & 63;
    bf16_t* H = (bf16_t*)(p.ws + WS_BIG);
    float nws[2][8], nwg[8], nwl[8];
#pragma unroll
    for (int j = 0; j < 8; ++j) { nws[0][j] = p.in[7][layer * 1024 + 8 * lane + j]; nws[1][j] = p.in[7][layer * 1024 + 512 + 8 * lane + j]; nwg[j] = p.in[11][layer * 128 + ((8 * lane + j) & 127)]; nwl[j] = p.in[14][layer * 128 + ((8 * lane + j) & 127)]; }
    for (int tok = blockIdx.x * 8 + wid; tok < MTOK; tok += gridDim.x * 8) {
        bf16_t* row = H + (size_t)tok * HP;
#pragma unroll
        for (int g = 0; g < 2; ++g) { float v[8]; unpack8(*(const u32x4*)(row + C_Z + 512 * g + 8 * lane), v); float s = 0.f;
#pragma unroll
            for (int j = 0; j < 8; ++j) s += v[j] * v[j];
#pragma unroll
            for (int o = 1; o < 64; o <<= 1) s += __shfl_xor(s, o);
            const float rs = rsqrtf(s * (1.f / 512.f) + RMS_EPS);
#pragma unroll
            for (int j = 0; j < 8; ++j) v[j] = v[j] * rs * nws[g][j];
            *(u32x4*)(row + C_Z + 512 * g + 8 * lane) = pack8(v); }
#pragma unroll
        for (int br = 0; br < 2; ++br) { const int craw = br == 0 ? C_GQKV : C_LQKV + 512, cgt = br == 0 ? C_GG : C_LR;
            float v[8], gt[8]; unpack8(*(const u32x4*)(row + craw + 8 * lane), v); unpack8(*(const u32x4*)(row + cgt + 8 * lane), gt); float s = 0.f;
#pragma unroll
            for (int j = 0; j < 8; ++j) s += v[j] * v[j];
#pragma unroll
            for (int o = 1; o < 16; o <<= 1) s += __shfl_xor(s, o);
            const float rs = rsqrtf(s * (1.f / 128.f) + RMS_EPS);
#pragma unroll
            for (int j = 0; j < 8; ++j) v[j] = v[j] * rs * (br == 0 ? nwg[j] : nwl[j]) * siluf_(gt[j]);
            *(u32x4*)(row + cgt + 8 * lane) = pack8(v); }
    }
}
__device__ __forceinline__ void phase_ln(const Params& p, const float* gam, const float* bet) {
    const int tid = tid_(), wid = tid >> 6, lane = tid & 63;
    float* X = p.out; bf16_t* xb = (bf16_t*)(p.ws + WS_XB);
    f32x4 gv[4], bv[4];
#pragma unroll
    for (int j = 0; j < 4; ++j) { gv[j] = *(const f32x4*)(gam + 256 * j + 4 * lane); bv[j] = *(const f32x4*)(bet + 256 * j + 4 * lane); }
    for (int row = blockIdx.x * 8 + wid; row < MTOK; row += gridDim.x * 8) {
        float* xr = X + (size_t)row * DM; f32x4 v[4]; float s = 0.f;
#pragma unroll
        for (int j = 0; j < 4; ++j) { v[j] = *(const f32x4*)(xr + 256 * j + 4 * lane); s += (v[j][0] + v[j][1]) + (v[j][2] + v[j][3]); }
#pragma unroll
        for (int o = 1; o < 64; o <<= 1) s += __shfl_xor(s, o);
        const float mean = s * (1.f / DM); float q = 0.f;
#pragma unroll
        for (int j = 0; j < 4; ++j) { v[j] = v[j] - mean; q += (v[j][0] * v[j][0] + v[j][1] * v[j][1]) + (v[j][2] * v[j][2] + v[j][3] * v[j][3]); }
#pragma unroll
        for (int o = 1; o < 64; o <<= 1) q += __shfl_xor(q, o);
        const float rstd = rsqrtf(q * (1.f / DM) + LN_EPS);
#pragma unroll
        for (int j = 0; j < 4; ++j) { const f32x4 o = v[j] * rstd * gv[j] + bv[j]; *(f32x4*)(xr + 256 * j + 4 * lane) = o;
            uint2 w; w.x = pk2(o[0], o[1]); w.y = pk2(o[2], o[3]); *(uint2*)(xb + (size_t)row * DM + 256 * j + 4 * lane) = w; }
    }
}
__device__ __forceinline__ void phase_convglu(const Params& p, int layer) {
    const int tid = tid_(), seg = tid >> 4, il = tid & 15;
    bf16_t* U = (bf16_t*)(p.ws + WS_BIG);
    const float* cw = p.in[22] + (size_t)layer * 3 * FF2; const float* cbp = p.in[23] + (size_t)layer * FF2;
    for (int w = blockIdx.x; w < NB * 22; w += gridDim.x) {
        const int b = w / 22, cgp = (w % 22) * 16 + il, c0 = cgp * 8;
        float wg[3][8], wu[3][8], bg[8], bu[8];
#pragma unroll
        for (int j = 0; j < 8; ++j) { bg[j] = cbp[c0 + j]; bu[j] = cbp[FF + c0 + j];
#pragma unroll
            for (int k = 0; k < 3; ++k) { wg[k][j] = cw[k * FF2 + c0 + j]; wu[k][j] = cw[k * FF2 + FF + c0 + j]; } }
        bf16_t* base = U + ((size_t)b * SEQ + seg * 64) * FF2 + c0;
        float g2[8], g1[8], u2[8], u1[8];
        if (seg > 0) { unpack8(*(const u32x4*)(base - 2 * (size_t)FF2), g2); unpack8(*(const u32x4*)(base - (size_t)FF2), g1); unpack8(*(const u32x4*)(base - 2 * (size_t)FF2 + FF), u2); unpack8(*(const u32x4*)(base - (size_t)FF2 + FF), u1); }
        else {
#pragma unroll
            for (int j = 0; j < 8; ++j) { g2[j] = 0.f; g1[j] = 0.f; u2[j] = 0.f; u1[j] = 0.f; } }
        __syncthreads();
#pragma unroll 4
        for (int r = 0; r < 64; ++r) { bf16_t* rp = base + (size_t)r * FF2; float gc[8], uc[8], o[8]; unpack8(*(const u32x4*)rp, gc); unpack8(*(const u32x4*)(rp + FF), uc);
#pragma unroll
            for (int j = 0; j < 8; ++j) { const float gg = wg[0][j] * g2[j] + wg[1][j] * g1[j] + wg[2][j] * gc[j] + bg[j], uu = wu[0][j] * u2[j] + wu[1][j] * u1[j] + wu[2][j] * uc[j] + bu[j];
                o[j] = siluf_(gg) * uu; g2[j] = g1[j]; g1[j] = gc[j]; u2[j] = u1[j]; u1[j] = uc[j]; }
            *(u32x4*)rp = pack8(o); }
        __syncthreads();
    }
}

#ifndef ONLY
#define ONLY -1
#endif
#ifndef DBG_SKIP
#define DBG_SKIP 0
#endif
#ifndef PHMASK
#define PHMASK 0xFFFF
#endif
#define PH(n) ((ONLY < 0 || ONLY == (n)) && ((PHMASK >> (n)) & 1))
__global__ void __launch_bounds__(512) mega_fwd(Params p) {
    extern __shared__ __attribute__((aligned(16))) unsigned char shm[];
    LAS unsigned char* lds = (LAS unsigned char*)shm;
    cg::grid_group grid = cg::this_grid();
    unsigned char* ws = p.ws;
    bf16_t* XB = (bf16_t*)(ws + WS_XB); bf16_t* H = (bf16_t*)(ws + WS_BIG);
    const bf16_t* W1 = (const bf16_t*)(ws + W_W1); const bf16_t* WG = (const bf16_t*)(ws + W_G);
    bf16_t* SG = H + C_XBC; bf16_t* MX = H + C_GQKV;
#pragma unroll 1
    for (int layer = 0; layer < DEPTH; ++layer) {
#pragma unroll 1
        for (int st = 0; st < 16; ++st) {
            GJob j; bool isg = false, sync = true;
            j.A = XB; j.lda = DM; j.Bt = W1; j.ldb = DM; j.N = DM; j.K = DM; j.E.mode = 0; j.E.O = H; j.E.ldc = HP; j.E.Sg = SG; j.E.base = p.out; j.E.out = p.out;
            switch (st) {
            case 0: if (PH(0)) { phase_convert(p, layer, lds); if (layer == 0) phase_x_to_bf16(p); } break;
            case 1: isg = true; j.N = HP; break;
            case 2: if (PH(3)) phase_mixers(p, layer, lds); break;
            case 3: if (PH(4)) phase_finalize(p, layer); break;
            case 4: isg = true; sync = false; j.Bt = WG; j.E.mode = 1; j.E.O = SG; break;
            case 5: isg = true; sync = false; j.A = H + C_Z; j.lda = HP; j.Bt = (const bf16_t*)(ws + W_PS); j.ldb = 1024; j.K = 1024; j.E.mode = 2; j.E.O = MX; break;
            case 6: isg = true; sync = false; j.Bt = WG + (size_t)1024 * 1024; j.E.mode = 1; j.E.O = SG; break;
            case 7: isg = true; sync = false; j.A = H + C_GG; j.lda = HP; j.Bt = (const bf16_t*)(ws + W_PG); j.ldb = 512; j.K = 512; j.E.mode = 3; j.E.O = MX; break;
            case 8: isg = true; sync = false; j.Bt = WG + (size_t)2048 * 1024; j.E.mode = 1; j.E.O = SG; break;
            case 9: isg = true; j.A = H + C_LR; j.lda = HP; j.Bt = (const bf16_t*)(ws + W_PL); j.ldb = 512; j.K = 512; j.E.mode = 3; j.E.O = MX; break;
            case 10: isg = true; j.A = MX; j.lda = HP; j.Bt = (const bf16_t*)(ws + W_O); j.E.mode = 4; j.E.base = layer == 0 ? p.in[0] : p.out; break;
            case 11: if (PH(7)) phase_ln(p, p.in[19] + layer * DM, p.in[20] + layer * DM); break;
            case 12: isg = true; j.Bt = (const bf16_t*)(ws + W_UP); j.N = FF2; j.E.ldc = FF2; break;
            case 13: if (PH(9)) phase_convglu(p, layer); break;
            case 14: isg = true; j.A = H; j.lda = FF2; j.Bt = (const bf16_t*)(ws + W_DN); j.ldb = FF; j.K = FF; j.E.mode = 4; break;
            default: if (PH(7)) phase_ln(p, p.in[25] + layer * DM, p.in[26] + layer * DM); break;
            }
            if ((DBG_SKIP & 1) && (st == 4 || st == 5)) isg = false;
            if ((DBG_SKIP & 2) && (st == 6 || st == 7)) isg = false;
            if ((DBG_SKIP & 4) && (st == 8 || st == 9)) isg = false;
            if (DBG_SKIP == 7 && st == 9) { isg = true; j.E.mode = 5; j.E.O = MX; }
            if ((DBG_SKIP & 1) && st == 7) j.E.mode = 2;
            if ((DBG_SKIP & 3) == 3 && st == 9) j.E.mode = 2;
            if (PH(1) && isg) run_gemm(lds, j);
            if (st == 1 && PH(2)) phase_small(p);
            if (sync) grid.sync();
        }
    }
}

extern "C" void kernel_launch(void* const* d_in, const int* in_sizes, int n_in, void* d_out, int out_size, void* d_ws, size_t ws_size, hipStream_t stream) {
    static int grid_blocks = 0;
    if (grid_blocks == 0) {
        if (n_in != 27 || out_size != MTOK * DM || ws_size < WS_END) { fprintf(stderr, "kernel_launch: unexpected shapes (n_in %d out %d ws %zu need %zu)\n", n_in, out_size, ws_size, (size_t)WS_END); grid_blocks = -1; return; }
        int dev = 0, cus = 0, per_cu = 0;
        (void)hipGetDevice(&dev); (void)hipDeviceGetAttribute(&cus, hipDeviceAttributeMultiprocessorCount, dev);
        if (hipFuncSetAttribute((const void*)mega_fwd, hipFuncAttributeMaxDynamicSharedMemorySize, LDS_BYTES) != hipSuccess) { fprintf(stderr, "kernel_launch: hipFuncSetAttribute failed\n"); grid_blocks = -1; return; }
        if (hipOccupancyMaxActiveBlocksPerMultiprocessor(&per_cu, (const void*)mega_fwd, 512, LDS_BYTES) != hipSuccess || per_cu < 1) { fprintf(stderr, "kernel_launch: occupancy query failed (%d)\n", per_cu); grid_blocks = -1; return; }
        grid_blocks = cus * per_cu; if (grid_blocks > 256) grid_blocks = 256;
        fprintf(stderr, "kernel_launch: %d CUs x %d -> grid %d\n", cus, per_cu, grid_blocks);
    }
    if (grid_blocks < 0) return;
    Params p{};
    for (int i = 0; i < 27; ++i) p.in[i] = (const float*)d_in[i];
    p.out = (float*)d_out; p.ws = (unsigned char*)d_ws;
    void* args[] = {&p};
    hipError_t e = hipLaunchCooperativeKernel((const void*)mega_fwd, dim3(grid_blocks), dim3(512), args, LDS_BYTES, stream);
    if (e != hipSuccess) fprintf(stderr, "kernel_launch: cooperative launch failed: %s (grid %d)\n", hipGetErrorString(e), grid_blocks);
}
```

```cpp
#include <hip/hip_runtime.h>
#include <hip/hip_cooperative_groups.h>
#include <cstdio>
namespace cg = cooperative_groups;
__device__ __forceinline__ int tid_() { int t = threadIdx.x; asm volatile("" : "+v"(t)); return t; }

namespace pg8 {
#define PG8_LAS __attribute__((address_space(3)))
typedef unsigned short bf16_t;
typedef short bf16x8 __attribute__((ext_vector_type(8)));
typedef float f32x4 __attribute__((ext_vector_type(4)));
typedef unsigned u32x4 __attribute__((ext_vector_type(4)));
constexpr int BM = 256, BK = 64, HALF = 128, HTB = HALF * BK * 2  , STAGE_BYTES = 8 * HTB, NXCD = 8, WGM = 8;

__host__ __device__ __forceinline__ int lds_byte(int r, int c) { const int st = (r >> 4) * 2 + (c >> 5), rr = r & 15, cc = c & 31, ob = rr * 64 + cc * 2; return st * 1024 + (ob ^ (((ob >> 9) & 1) << 5)); }
__host__ __device__ __forceinline__ void stage_rc(int b, int& R, int& C) { const int st = b / 1024, sb = b % 1024, swz = sb ^ (((sb >> 9) & 1) << 5); R = (st >> 1) * 16 + swz / 64; C = (st & 1) * 32 + (swz % 64) / 2; }
__host__ __device__ __forceinline__ int perm32(int rho) { const int n = rho >> 4, i = rho & 15; return 8 * (i >> 2) + 4 * n + (i & 3); }

struct Unit { int pm, pn; };
struct Gemm { const bf16_t* A; const bf16_t* Bt; int M, N, K, lda, ldb; };

struct StaticOrder {
    int nM, nN, nwg, G, c;
    __host__ __device__ void init(int M, int N, int G_, int c_) { nM = M / BM; nN = N / BM; nwg = nM * nN; G = G_; c = c_; }
    __host__ __device__ bool next(int i, Unit& u) const {
        const long L = (long)i * G + c; if (L >= nwg) return false;
        int wgid = (int)L; { const int q = nwg / NXCD, r = nwg % NXCD, xcd = wgid % NXCD, off = wgid / NXCD; wgid = (xcd < r ? xcd * (q + 1) : r * (q + 1) + (xcd - r) * q) + off; }
        const int nig = WGM * nN, gid = wgid / nig, fm = gid * WGM, gsz = (nM - fm) < WGM ? (nM - fm) : WGM;
        u.pm = fm + ((wgid % nig) % gsz); u.pn = (wgid % nig) / gsz; return true;
    }
    __device__ __forceinline__ void a_ready(const Unit&) const {}
    __device__ __forceinline__ void done(const Unit&) const {}
};
__device__ __forceinline__ unsigned cvt_pk_bf16(float lo, float hi) { unsigned r; asm volatile("v_cvt_pk_bf16_f32 %0, %1, %2" : "=v"(r) : "v"(lo), "v"(hi)); return r; }
typedef float f32x2 __attribute__((ext_vector_type(2)));
template <class Epi, class Sched, bool STAMP = false>
__device__ __forceinline__ void gemm_phase(PG8_LAS unsigned char* lds, const Gemm g, const Sched& S, const Epi& E, unsigned long long* stamps) {
    const int tid = tid_(), wid = __builtin_amdgcn_readfirstlane(tid >> 6), lane = tid & 63, wr = wid >> 2, wc = wid & 3, fr = lane & 15, fq = lane >> 4;
    const int K = g.K, nt = K / BK;
    int ts_lo = 0, ts_hi = 0, nts = 0; const unsigned long long rt_entry = STAMP ? (unsigned long long)wall_clock64() : 0ull;
#define PG8_STAMP() do { if (STAMP && wid == 0 && nts < 64) { const unsigned long long _c = (unsigned long long)clock64(); \
        ts_lo = (lane == nts) ? (int)(unsigned)_c : ts_lo; ts_hi = (lane == nts) ? (int)(unsigned)(_c >> 32) : ts_hi; ++nts; } } while (0)
    PG8_STAMP();
    unsigned voffA[2], voffB[2];
#pragma unroll
    for (int i = 0; i < 2; ++i) { int R, C; stage_rc(tid * 16 + i * 8192, R, C); const int Rb = Epi::PERM ? ((R & ~31) + perm32(R & 31)) : R;
        voffA[i] = (unsigned)(R * g.lda + C) * 2u; voffB[i] = (unsigned)(Rb * g.ldb + C) * 2u; }
    const size_t kstep = (size_t)(BK * 2);
    const size_t hstepA = (size_t)HALF * g.lda * 2, hstepB = (size_t)HALF * g.ldb * 2;
    const size_t tstepA = 2 * hstepA, tstepB = 2 * hstepB;
    const unsigned ldsw = (unsigned)wid * 1024u;
    const int aoff = lds_byte(wr * 64 + fr, fq * 8), boff = lds_byte(wc * 32 + fr, fq * 8);
#define PG8_SA(b, h) (((b) * 2 + (h)) * HTB)
#define PG8_SB(b, h) ((4 + (b) * 2 + (h)) * HTB)
#define PG8_STAGE(bufoff, gbase, voff) do { _Pragma("unroll") for (int _i = 0; _i < 2; ++_i) \
        __builtin_amdgcn_global_load_lds((const unsigned*)((const char*)(gbase) + (voff)[_i]), (PG8_LAS unsigned*)(lds + (bufoff) + ldsw + _i * 8192), 16, 0, 0); } while (0)
#define PG8_LDA(dst, b, h) do { _Pragma("unroll") for (int m = 0; m < 4; ++m) _Pragma("unroll") for (int k = 0; k < 2; ++k) dst[m][k] = *(const PG8_LAS bf16x8*)(lds + PG8_SA(b, h) + aoff + m * 2048 + k * 1024); } while (0)
#define PG8_LDB(dst, b, h) do { _Pragma("unroll") for (int n = 0; n < 2; ++n) _Pragma("unroll") for (int k = 0; k < 2; ++k) dst[n][k] = *(const PG8_LAS bf16x8*)(lds + PG8_SB(b, h) + boff + n * 2048 + k * 1024); } while (0)
#define PG8_MMA(ai, bj, At, Bt) do { __builtin_amdgcn_s_setprio(1); _Pragma("unroll") for (int m = 0; m < 4; ++m) _Pragma("unroll") for (int n = 0; n < 2; ++n) _Pragma("unroll") for (int k = 0; k < 2; ++k) \
        acc[ai][bj][m][n] = __builtin_amdgcn_mfma_f32_16x16x32_bf16(Bt[n][k], At[m][k], acc[ai][bj][m][n], 0, 0, 0); __builtin_amdgcn_s_setprio(0); } while (0)
#define PG8_WAIT_V(n) asm volatile("s_waitcnt vmcnt(" #n ")" ::: "memory")
#define PG8_WAIT_L(n) asm volatile("s_waitcnt lgkmcnt(" #n ")" ::: "memory")
#define PG8_BAR __builtin_amdgcn_s_barrier()
#define PG8_SCHED __builtin_amdgcn_sched_barrier(0)
    Unit cur, nxt; int ui = 0;
    if (!S.next(0, cur)) return;
    f32x4 acc[2][2][4][2];
#pragma unroll
    for (int a = 0; a < 2; ++a)
#pragma unroll
        for (int b = 0; b < 2; ++b)
#pragma unroll
            for (int m = 0; m < 4; ++m)
#pragma unroll
                for (int n = 0; n < 2; ++n) acc[a][b][m][n] = (f32x4){0.f, 0.f, 0.f, 0.f};
    bf16x8 At[4][2], B0[2][2], B1[2][2];
    const char* cA = (const char*)g.A + (size_t)cur.pm * tstepA; const char* cB = (const char*)g.Bt + (size_t)cur.pn * tstepB;
    S.a_ready(cur);
    PG8_STAGE(PG8_SB(0, 0), cB, voffB); PG8_STAGE(PG8_SA(0, 0), cA, voffA); PG8_STAGE(PG8_SB(0, 1), cB + hstepB, voffB); PG8_STAGE(PG8_SA(0, 1), cA + hstepA, voffA);
    if (wr == 1) PG8_BAR;
    PG8_WAIT_V(4); PG8_BAR;
    PG8_STAGE(PG8_SB(1, 0), cB + kstep, voffB); PG8_STAGE(PG8_SA(1, 0), cA + kstep, voffA); PG8_STAGE(PG8_SB(1, 1), cB + hstepB + kstep, voffB);
    PG8_WAIT_V(6); PG8_BAR;
    PG8_STAMP();
    for (;;) {
        const bool has_next = S.next(ui + 1, nxt);
        const char* nA = has_next ? (const char*)g.A + (size_t)nxt.pm * tstepA : cA; const char* nB = has_next ? (const char*)g.Bt + (size_t)nxt.pn * tstepB : cB;
        for (int t = 0; t < nt; t += 2) {
            const bool last = (t == nt - 2);
            const char* a1 = cA + (size_t)(t + 1) * kstep;
            const char* a2 = last ? nA : cA + (size_t)(t + 2) * kstep; const char* b2 = last ? nB : cB + (size_t)(t + 2) * kstep;
            const char* a3 = a2 + kstep; const char* b3 = b2 + kstep;
            if (last && has_next) S.a_ready(nxt);
            PG8_LDB(B0, 0, 0); PG8_SCHED; PG8_LDA(At, 0, 0); PG8_STAGE(PG8_SA(1, 1), a1 + hstepA, voffA);
            PG8_WAIT_L(8); PG8_BAR; PG8_WAIT_L(0); PG8_MMA(0, 0, At, B0); PG8_BAR; PG8_SCHED;
            PG8_LDB(B1, 0, 1); PG8_STAGE(PG8_SB(0, 0), b2, voffB);
            PG8_BAR; PG8_WAIT_L(0); PG8_MMA(0, 1, At, B1); PG8_BAR;
            PG8_LDA(At, 0, 1); PG8_STAGE(PG8_SA(0, 0), a2, voffA);
            PG8_BAR; PG8_WAIT_L(0); PG8_MMA(1, 0, At, B0); PG8_BAR; PG8_SCHED;
            PG8_STAGE(PG8_SB(0, 1), b2 + hstepB, voffB);
            PG8_WAIT_V(6); PG8_BAR; PG8_MMA(1, 1, At, B1); PG8_BAR;
            PG8_LDB(B0, 1, 0); PG8_SCHED; PG8_LDA(At, 1, 0); PG8_STAGE(PG8_SA(0, 1), a2 + hstepA, voffA);
            PG8_WAIT_L(8); PG8_BAR; PG8_WAIT_L(0); PG8_MMA(0, 0, At, B0); PG8_BAR; PG8_SCHED;
            PG8_LDB(B1, 1, 1); PG8_STAGE(PG8_SB(1, 0), b3, voffB);
            PG8_BAR; PG8_WAIT_L(0); PG8_MMA(0, 1, At, B1); PG8_BAR;
            PG8_LDA(At, 1, 1); PG8_STAGE(PG8_SA(1, 0), a3, voffA);
            PG8_BAR; PG8_WAIT_L(0); PG8_MMA(1, 0, At, B0); PG8_BAR; PG8_SCHED;
            PG8_STAGE(PG8_SB(1, 1), b3 + hstepB, voffB);
            PG8_WAIT_V(6); PG8_BAR; PG8_MMA(1, 1, At, B1); PG8_BAR;
        }
        PG8_STAMP();
        if constexpr (!Epi::AFTER_DRAIN) { E(acc, cur, wr, wc, fr, fq); S.done(cur); }
        PG8_STAMP();
        if (!has_next) break;
#pragma unroll
        for (int a = 0; a < 2; ++a)
#pragma unroll
            for (int b = 0; b < 2; ++b)
#pragma unroll
                for (int m = 0; m < 4; ++m)
#pragma unroll
                    for (int n = 0; n < 2; ++n) acc[a][b][m][n] = (f32x4){0.f, 0.f, 0.f, 0.f};
        cur = nxt; cA = nA; cB = nB; ++ui;
    }
    PG8_WAIT_V(0);
    if (wr == 0) PG8_BAR;
    PG8_BAR;
    if constexpr (Epi::AFTER_DRAIN) { E.fused(acc, cur, wr, wc, fr, fq, lds, wid, lane); S.done(cur); }
    PG8_STAMP();
    if (STAMP && wid == 0) { stamps[lane] = lane < nts ? (((unsigned long long)(unsigned)ts_hi << 32) | (unsigned)ts_lo) : 0ull;
        if (lane == 62) stamps[62] = rt_entry; if (lane == 63) stamps[63] = (unsigned long long)wall_clock64(); }
#undef PG8_STAMP
#undef PG8_SA
#undef PG8_SB
#undef PG8_STAGE
#undef PG8_LDA
#undef PG8_LDB
#undef PG8_MMA
#undef PG8_WAIT_V
#undef PG8_WAIT_L
#undef PG8_BAR
#undef PG8_SCHED
}
}

using pg8::bf16_t; using pg8::bf16x8; using pg8::f32x4; using pg8::u32x4;
#define LAS __attribute__((address_space(3)))
constexpr int DM = 1024, NB = 8, SEQ = 2048, MTOK = NB * SEQ, DEPTH = 2, IN_DIM = 9256;
constexpr int HP = 6144;
constexpr int C_Z = 0, C_XBC = 1024, C_GQKV = 2560, C_GG = 4096, C_LQKV = 4608, C_LR = 5632;
constexpr int O_Z = 0, O_XBC = 1024, O_DT = 2560, O_GQKV = 2576, O_GA = 4112, O_GB = 4116, O_GG = 4120, O_LQKV = 4632, O_GLR = 5656, O_LR = 5672, O_GATES = 6184;
constexpr int HS = 64;
constexpr int FF = 2816, FF2 = 5632;
constexpr float ALPHA = 1.41421356237f, LN_EPS = 1e-5f, RMS_EPS = 1e-6f;
constexpr int LDS_BYTES = 160 * 1024;
constexpr size_t W_W1 = 0, W_SM = W_W1 + (size_t)6144 * 1024 * 2, W_G = W_SM + (size_t)64 * 1024 * 2, W_PS = W_G + (size_t)3072 * 1024 * 2, W_PG = W_PS + (size_t)1024 * 1024 * 2,
                 W_PL = W_PG + (size_t)1024 * 512 * 2, W_O = W_PL + (size_t)1024 * 512 * 2, W_UP = W_O + (size_t)1024 * 1024 * 2, W_DN = W_UP + (size_t)5632 * 1024 * 2,
                 WS_XB = W_DN + (size_t)1024 * 2816 * 2, WS_HS = WS_XB + (size_t)MTOK * 1024 * 2, WS_BIG = WS_HS + (size_t)MTOK * HS * 4, WS_GO = WS_BIG + (size_t)MTOK * HP * 2, WS_BAR = WS_GO + (size_t)MTOK * 512 * 2, WS_END = WS_BAR + 16384;

struct Params { const float* in[27]; float* out; unsigned char* ws; };

__device__ __forceinline__ float bf2f(bf16_t v) { return __uint_as_float(((unsigned)v) << 16); }
__device__ __forceinline__ bf16_t f2bf(float f) { unsigned u = __float_as_uint(f); u += 0x7FFFu + ((u >> 16) & 1u); return (bf16_t)(u >> 16); }
__device__ __forceinline__ unsigned pk2(float lo, float hi) { unsigned r; asm("v_cvt_pk_bf16_f32 %0, %1, %2" : "=v"(r) : "v"(lo), "v"(hi)); return r; }
__device__ __forceinline__ float sigmoidf_(float x) { return 1.0f / (1.0f + __expf(-x)); }
__device__ __forceinline__ float siluf_(float x) { return x / (1.0f + __expf(-x)); }
__device__ __forceinline__ float softplusf_(float x) { return x > 20.f ? x : log1pf(__expf(x)); }
__device__ __forceinline__ void unpack8(const u32x4 w, float (&f)[8]) {
    f[0] = __uint_as_float(w.x << 16); f[1] = __uint_as_float(w.x & 0xffff0000u); f[2] = __uint_as_float(w.y << 16); f[3] = __uint_as_float(w.y & 0xffff0000u);
    f[4] = __uint_as_float(w.z << 16); f[5] = __uint_as_float(w.z & 0xffff0000u); f[6] = __uint_as_float(w.w << 16); f[7] = __uint_as_float(w.w & 0xffff0000u); }
__device__ __forceinline__ u32x4 pack8(const float (&f)[8]) { u32x4 w; w.x = pk2(f[0], f[1]); w.y = pk2(f[2], f[3]); w.z = pk2(f[4], f[5]); w.w = pk2(f[6], f[7]); return w; }

struct EpiU {
    static constexpr bool PERM = true, AFTER_DRAIN = false;
    int mode; bf16_t* O; int ldc; const bf16_t* Sg; const float* base; float* out;
    __device__ __forceinline__ void operator()(const f32x4 (&acc)[2][2][4][2], const pg8::Unit& u, int wr, int wc, int fr, int fq) const {
        const int row0 = u.pm * 256 + wr * 64 + fr, col0 = u.pn * 256 + wc * 32 + 8 * fq;
#pragma unroll
        for (int ai = 0; ai < 2; ++ai)
#pragma unroll
            for (int m = 0; m < 4; ++m) { const int row = row0 + ai * 128 + m * 16;
#pragma unroll
                for (int bj = 0; bj < 2; ++bj) { f32x4 v0 = acc[ai][bj][m][0], v1 = acc[ai][bj][m][1];
                    if (mode == 4) { const size_t off = (size_t)row * DM + col0 + bj * 128;
                        const f32x4 b0 = *(const f32x4*)(base + off), b1 = *(const f32x4*)(base + off + 4);
                        *(f32x4*)(out + off) = b0 * ALPHA + v0; *(f32x4*)(out + off + 4) = b1 * ALPHA + v1;
                    } else { const size_t off = (size_t)row * ldc + col0 + bj * 128;
                        if (mode == 5) { v0 = (f32x4){0.f, 0.f, 0.f, 0.f}; v1 = v0; }
                        if (mode == 1) {
#pragma unroll
                            for (int j = 0; j < 4; ++j) { v0[j] = sigmoidf_(v0[j]); v1[j] = sigmoidf_(v1[j]); } }
                        if (mode >= 2) { float sg[8]; unpack8(*(const u32x4*)(Sg + off), sg);
#pragma unroll
                            for (int j = 0; j < 4; ++j) { v0[j] *= sg[j]; v1[j] *= sg[4 + j]; }
                            if (mode == 3) { float o[8]; unpack8(*(const u32x4*)(O + off), o);
#pragma unroll
                                for (int j = 0; j < 4; ++j) { v0[j] += o[j]; v1[j] += o[4 + j]; } } }
                        u32x4 w; w.x = pk2(v0[0], v0[1]); w.y = pk2(v0[2], v0[3]); w.z = pk2(v1[0], v1[1]); w.w = pk2(v1[2], v1[3]);
                        *(u32x4*)(O + off) = w; } }
                asm volatile("" ::: "memory"); }
    }
};
struct GJob { const bf16_t* A; int lda; const bf16_t* Bt; int ldb; int N, K; EpiU E; };
__device__ __forceinline__ void run_gemm(LAS unsigned char* lds, const GJob& j, int vwg) {
    pg8::Gemm g; g.A = j.A; g.Bt = j.Bt; g.M = MTOK; g.N = j.N; g.K = j.K; g.lda = j.lda; g.ldb = j.ldb;
    pg8::StaticOrder S; S.init(MTOK, j.N, (int)gridDim.x, vwg);
    pg8::gemm_phase<EpiU, pg8::StaticOrder, false>(lds, g, S, j.E, nullptr);
}
__device__ __forceinline__ void tr_item(const float* W, int ldw, int col0, int K, int ncols, bf16_t* WT, int row_off, LAS float* scr, int item, int lane) {
    const int nblk = ncols / 32, kb = item / nblk, nb = item % nblk, k0 = 64 * kb, n0 = 32 * nb;
#pragma unroll 8
    for (int i = 0; i < 32; ++i) { const int kk = 2 * i + (lane >> 5); scr[kk * 33 + (lane & 31)] = W[(size_t)(k0 + kk) * ldw + col0 + n0 + (lane & 31)]; }
    asm volatile("s_waitcnt lgkmcnt(0)" ::: "memory");
    const int c = lane & 7;
#pragma unroll
    for (int j = 0; j < 4; ++j) { const int n = (lane >> 3) + 8 * j; const LAS float* s = scr + (8 * c) * 33 + n;
        u32x4 o; o.x = pk2(s[0 * 33], s[1 * 33]); o.y = pk2(s[2 * 33], s[3 * 33]); o.z = pk2(s[4 * 33], s[5 * 33]); o.w = pk2(s[6 * 33], s[7 * 33]);
        *(u32x4*)(WT + (size_t)(row_off + n0 + n) * K + k0 + 8 * c) = o; }
    asm volatile("s_waitcnt lgkmcnt(0)" ::: "memory");
}
__device__ __forceinline__ void phase_convert(const Params& p, int layer, LAS unsigned char* lds) {
    const int tid = tid_(), wid = tid >> 6, lane = tid & 63;
    LAS float* scr = (LAS float*)(lds + wid * 16384);
    unsigned char* ws = p.ws;
    const float* w_in = p.in[1] + (size_t)layer * DM * IN_DIM;
    bf16_t* W1 = (bf16_t*)(ws + W_W1); bf16_t* WG = (bf16_t*)(ws + W_G);
    const int gw = blockIdx.x * 8 + wid, NGW = gridDim.x * 8;
#define JOB(src, ldw, col0, K, ncols, dst, rowoff) { const int ni = ((K) / 64) * ((ncols) / 32); if (r < ni) { tr_item(src, ldw, col0, K, ncols, dst, rowoff, scr, r, lane); continue; } r -= ni; }
    for (int it = gw; ; it += NGW) {
        int r = it;
        JOB(w_in, IN_DIM, O_Z, 1024, 1024, W1, C_Z)
        JOB(w_in, IN_DIM, O_XBC, 1024, 1536, W1, C_XBC)
        JOB(w_in, IN_DIM, O_GQKV, 1024, 1536, W1, C_GQKV)
        JOB(w_in, IN_DIM, O_GG, 1024, 512, W1, C_GG)
        JOB(w_in, IN_DIM, O_LQKV, 1024, 1024, W1, C_LQKV)
        JOB(w_in, IN_DIM, O_LR, 1024, 512, W1, C_LR)
        JOB(w_in, IN_DIM, O_GATES, 1024, 3072, WG, 0)
        JOB(p.in[15] + (size_t)layer * 1024 * 1024, 1024, 0, 1024, 1024, (bf16_t*)(ws + W_PS), 0)
        JOB(p.in[16] + (size_t)layer * 512 * 1024, 1024, 0, 512, 1024, (bf16_t*)(ws + W_PG), 0)
        JOB(p.in[17] + (size_t)layer * 512 * 1024, 1024, 0, 512, 1024, (bf16_t*)(ws + W_PL), 0)
        JOB(p.in[18] + (size_t)layer * 1024 * 1024, 1024, 0, 1024, 1024, (bf16_t*)(ws + W_O), 0)
        JOB(p.in[21] + (size_t)layer * 1024 * FF2, FF2, 0, 1024, FF2, (bf16_t*)(ws + W_UP), 0)
        JOB(p.in[24] + (size_t)layer * FF * 1024, 1024, 0, FF, 1024, (bf16_t*)(ws + W_DN), 0)
        break;
    }
#undef JOB
    bf16_t* WS = (bf16_t*)(ws + W_SM);
    for (int i = blockIdx.x * 512 + tid; i < 64 * 1024; i += gridDim.x * 512) {
        const int n = i >> 10, k = i & 1023; int oc = -1;
        if (n < 16) oc = O_DT + n; else if (n < 20) oc = O_GA + n - 16; else if (n < 24) oc = O_GB + n - 20; else if (n < 40) oc = O_GLR + n - 24;
        WS[i] = oc >= 0 ? f2bf(w_in[(size_t)k * IN_DIM + oc]) : (bf16_t)0;
    }
}
__device__ __forceinline__ void phase_x_to_bf16(const Params& p) {
    const float* x = p.in[0]; bf16_t* xb = (bf16_t*)(p.ws + WS_XB);
    for (size_t i = (size_t)blockIdx.x * 512 + tid_(); i < (size_t)MTOK * DM / 8; i += (size_t)gridDim.x * 512) {
        const f32x4 a = *(const f32x4*)(x + i * 8), b = *(const f32x4*)(x + i * 8 + 4);
        u32x4 w; w.x = pk2(a[0], a[1]); w.y = pk2(a[2], a[3]); w.z = pk2(b[0], b[1]); w.w = pk2(b[2], b[3]);
        *(u32x4*)(xb + i * 8) = w; }
}
__device__ __forceinline__ void phase_small(const Params& p) {
    const int tid = tid_(), wid = tid >> 6, lane = tid & 63, fr = lane & 15, fq = lane >> 4, mt = wid & 3, np = wid >> 2;
    const bf16_t* xb = (const bf16_t*)(p.ws + WS_XB); const bf16_t* WS = (const bf16_t*)(p.ws + W_SM); float* hs = (float*)(p.ws + WS_HS);
    for (int rb = blockIdx.x; rb < MTOK / 64; rb += gridDim.x) {
        const int r0 = rb * 64;
        f32x4 a0 = {0.f, 0.f, 0.f, 0.f}, a1 = {0.f, 0.f, 0.f, 0.f};
        const bf16_t* ap = xb + (size_t)(r0 + 16 * mt + fr) * 1024 + 8 * fq; const bf16_t* b0p = WS + (size_t)(32 * np + fr) * 1024 + 8 * fq; const bf16_t* b1p = b0p + 16 * 1024;
#pragma unroll 4
        for (int kk = 0; kk < 32; ++kk) { const bf16x8 a = *(const bf16x8*)(ap + kk * 32), b0 = *(const bf16x8*)(b0p + kk * 32), b1 = *(const bf16x8*)(b1p + kk * 32);
            a0 = __builtin_amdgcn_mfma_f32_16x16x32_bf16(a, b0, a0, 0, 0, 0); a1 = __builtin_amdgcn_mfma_f32_16x16x32_bf16(a, b1, a1, 0, 0, 0); }
#pragma unroll
        for (int j = 0; j < 4; ++j) { float* o = hs + (size_t)(r0 + 16 * mt + 4 * fq + j) * HS + 32 * np + fr; o[0] = a0[j]; o[16] = a1[j]; }
    }
}

__device__ __forceinline__ void conv8_silu(const bf16_t* gp, int t, const LAS float* wt, int nch, int c8, bool bias, float (&o)[8]) {
    float acc[8];
#pragma unroll
    for (int j = 0; j < 8; ++j) acc[j] = bias ? wt[4 * nch + c8 + j] : 0.f;
#pragma unroll
    for (int k = 0; k < 4; ++k) { const int tt = t - 3 + k;
        if (tt >= 0) { float xv[8]; unpack8(*(const u32x4*)(gp + (ptrdiff_t)(k - 3) * HP), xv); const f32x4 wa = *(const LAS f32x4*)(wt + k * nch + c8), wb = *(const LAS f32x4*)(wt + k * nch + c8 + 4);
#pragma unroll
            for (int j = 0; j < 4; ++j) { acc[j] += wa[j] * xv[j]; acc[4 + j] += wb[j] * xv[4 + j]; } } }
#pragma unroll
    for (int j = 0; j < 8; ++j) o[j] = siluf_(acc[j]);
}
typedef float f32x2 __attribute__((ext_vector_type(2)));
template <int CTRL> __device__ __forceinline__ float dpp_add(float v) { const int x = __builtin_amdgcn_update_dpp(0, __float_as_int(v), CTRL, 0xF, 0xF, true); return v + __int_as_float(x); }
__device__ __forceinline__ float red4(float v) { v = dpp_add<0xB1>(v); return dpp_add<0x4E>(v); }
__device__ __forceinline__ float red8(float v) { return dpp_add<0x141>(red4(v)); }
__device__ __forceinline__ float red16(float v) { return dpp_add<0x140>(red8(v)); }
struct Raw4 { u32x4 r[4]; };
__device__ __forceinline__ void ld_taps(const bf16_t* gp, int t, Raw4& R) {
#pragma unroll
    for (int k = 0; k < 4; ++k) { const int tt = t - 3 + k; R.r[k] = tt >= 0 ? *(const u32x4*)(gp + (ptrdiff_t)(k - 3) * HP) : (u32x4){0u, 0u, 0u, 0u}; }
}
__device__ __forceinline__ void conv8_regs(const Raw4& R, const LAS float* wt, int nch, int c8, bool bias, float (&o)[8]) {
    float acc[8];
#pragma unroll
    for (int j = 0; j < 8; ++j) acc[j] = bias ? wt[4 * nch + c8 + j] : 0.f;
#pragma unroll
    for (int k = 0; k < 4; ++k) { float xv[8]; unpack8(R.r[k], xv); const f32x4 wa = *(const LAS f32x4*)(wt + k * nch + c8), wb = *(const LAS f32x4*)(wt + k * nch + c8 + 4);
#pragma unroll
        for (int j = 0; j < 4; ++j) { acc[j] += wa[j] * xv[j]; acc[4 + j] += wb[j] * xv[4 + j]; } }
#pragma unroll
    for (int j = 0; j < 8; ++j) o[j] = siluf_(acc[j]);
}
__device__ __forceinline__ void st8(LAS float* d, const float (&v)[8]) { *(LAS f32x4*)d = (f32x4){v[0], v[1], v[2], v[3]}; *(LAS f32x4*)(d + 4) = (f32x4){v[4], v[5], v[6], v[7]}; }

__device__ __forceinline__ void ssd_chain(const Params& p, int layer, int idx, LAS unsigned char* lds, bool dry) {
    const int tid = tid_(), b = idx >> 4, head = idx & 15, grp = head >> 3;
    bf16_t* H = (bf16_t*)(p.ws + WS_BIG) + (size_t)b * SEQ * HP; const float* hs = (const float*)(p.ws + WS_HS) + (size_t)b * SEQ * HS;
    LAS float* dts = (LAS float*)lds;
    LAS float* wt  = (LAS float*)(lds + 8192);
    LAS float* xs  = (LAS float*)(lds + 16384);
    LAS float* zs  = xs + 64 * 64;
    LAS float* Bs  = zs + 64 * 64;
    LAS float* Cs  = Bs + 64 * 128;
    LAS float* dAs = Cs + 64 * 128;
    LAS float* dxs = dAs + 2048;
    LAS float* yb  = dxs + 64 * 64;
    const float A = -__expf(p.in[5][layer * 16 + head]), Dk = p.in[6][layer * 16 + head], dtb = p.in[4][layer * 16 + head];
    for (int t = tid; t < SEQ; t += 512) { const float d = softplusf_(hs[(size_t)t * HS + head] + dtb); dts[t] = d; dAs[t] = __expf(d * A); }
    if (tid < 320) { const int ch = tid < 64 ? head * 64 + tid : (tid < 192 ? 1024 + grp * 128 + (tid - 64) : 1280 + grp * 128 + (tid - 192));
        const float* cw = p.in[2] + (size_t)layer * 4 * 1536;
#pragma unroll
        for (int k = 0; k < 4; ++k) wt[k * 320 + tid] = cw[k * 1536 + ch];
        wt[4 * 320 + tid] = p.in[3][layer * 1536 + ch]; }
    const int pp = tid >> 3, ns = tid & 7;
    f32x2 h2[8];
#pragma unroll
    for (int j = 0; j < 8; ++j) h2[j] = (f32x2){0.f, 0.f};
    Raw4 Rx, RB[2], RC[2]; u32x4 Rz;
    auto ssd_load = [&](int tb) {
        { const int l = tid >> 3, g8 = (tid & 7) * 8; ld_taps(H + (size_t)(tb + l) * HP + C_XBC + head * 64 + g8, tb + l, Rx); Rz = *(const u32x4*)(H + (size_t)(tb + l) * HP + C_Z + head * 64 + g8); }
#pragma unroll
        for (int i = 0; i < 2; ++i) { const int it = tid + 512 * i, l = it >> 4, g8 = (it & 15) * 8;
          ld_taps(H + (size_t)(tb + l) * HP + C_XBC + 1024 + grp * 128 + g8, tb + l, RB[i]); ld_taps(H + (size_t)(tb + l) * HP + C_XBC + 1280 + grp * 128 + g8, tb + l, RC[i]); }
    };
    ssd_load(0);
    __syncthreads();
#pragma unroll 1
    for (int c = 0; c < SEQ / 64; ++c) {
        const int t0 = c * 64;
        { const int l = tid >> 3, g8 = (tid & 7) * 8; float v[8];
          conv8_regs(Rx, wt, 320, g8, true, v); st8(xs + l * 64 + g8, v);
          { const float d = dts[t0 + l]; float dv[8];
#pragma unroll
            for (int j = 0; j < 8; ++j) dv[j] = d * v[j];
            st8(dxs + l * 64 + g8, dv); }
          unpack8(Rz, v); st8(zs + l * 64 + g8, v); }
#pragma unroll
        for (int i = 0; i < 2; ++i) { const int it = tid + 512 * i, l = it >> 4, g8 = (it & 15) * 8; float v[8];
          conv8_regs(RB[i], wt, 320, 64 + g8, true, v); st8(Bs + l * 128 + g8, v);
          conv8_regs(RC[i], wt, 320, 192 + g8, true, v); st8(Cs + l * 128 + g8, v); }
        __syncthreads();
        if (c + 1 < SEQ / 64) ssd_load(t0 + 64);
#pragma unroll 1
        for (int l8 = 0; l8 < 64; l8 += 8) { float ykeep = 0.f;
#pragma unroll
            for (int i = 0; i < 8; ++i) { const int l = l8 + i;
                const float dA = dAs[t0 + l], dx = dxs[l * 64 + pp]; const f32x2 dA2 = {dA, dA}, dx2 = {dx, dx}; f32x2 y2 = {0.f, 0.f};
#pragma unroll
                for (int j4 = 0; j4 < 4; ++j4) { const f32x4 Bv = *(const LAS f32x4*)(Bs + l * 128 + 16 * ns + 4 * j4), Cv = *(const LAS f32x4*)(Cs + l * 128 + 16 * ns + 4 * j4);
                    h2[2 * j4] = h2[2 * j4] * dA2 + dx2 * (f32x2){Bv[0], Bv[1]}; h2[2 * j4 + 1] = h2[2 * j4 + 1] * dA2 + dx2 * (f32x2){Bv[2], Bv[3]};
                    y2 += (f32x2){Cv[0], Cv[1]} * h2[2 * j4]; y2 += (f32x2){Cv[2], Cv[3]} * h2[2 * j4 + 1]; }
                const float y = red8(y2[0] + y2[1]);
                ykeep = (ns == i) ? y : ykeep; }
            yb[(l8 + ns) * 64 + pp] = ykeep; }
        __syncthreads();
        { const int l = tid >> 3, g8 = (tid & 7) * 8; float o[8];
#pragma unroll
          for (int j = 0; j < 8; ++j) o[j] = (yb[l * 64 + g8 + j] + Dk * xs[l * 64 + g8 + j]) * siluf_(zs[l * 64 + g8 + j]);
          if (!dry) *(u32x4*)(H + (size_t)(t0 + l) * HP + C_Z + head * 64 + g8) = pack8(o); }
        __syncthreads();
    }
}
__device__ __forceinline__ void gdn_chain(const Params& p, int layer, int idx, LAS unsigned char* lds, bool dry) {
    const int tid = tid_(), bh = idx >> 1, vh = idx & 1, b = bh >> 2, hh = bh & 3;
    const bf16_t* H = (const bf16_t*)(p.ws + WS_BIG) + (size_t)b * SEQ * HP; const float* hs = (const float*)(p.ws + WS_HS) + (size_t)b * SEQ * HS;
    bf16_t* GO = (bf16_t*)(p.ws + WS_GO) + (size_t)b * SEQ * 512;
    LAS float* egs = (LAS float*)lds;
    LAS float* bts = egs + 2048;
    LAS float* wt  = bts + 2048;
    LAS float* qs  = wt + 4 * 320;
    LAS float* ks  = qs + 64 * 128;
    LAS float* vs  = ks + 64 * 128;
    LAS float* ob  = vs + 64 * 64;
    const float An = -__expf(p.in[9][layer * 4 + hh]), dtb = p.in[10][layer * 4 + hh];
    for (int t = tid; t < SEQ; t += 512) { egs[t] = __expf(An * softplusf_(hs[(size_t)t * HS + 16 + hh] + dtb)); bts[t] = sigmoidf_(hs[(size_t)t * HS + 20 + hh]); }
    if (tid < 320) { const int ch = tid < 128 ? hh * 128 + tid : (tid < 256 ? 512 + hh * 128 + (tid - 128) : 1024 + hh * 128 + vh * 64 + (tid - 256));
        const float* cw = p.in[8] + (size_t)layer * 4 * 1536;
#pragma unroll
        for (int k = 0; k < 4; ++k) wt[k * 320 + tid] = cw[k * 1536 + ch]; }
    const int vloc = tid >> 3, part = tid & 7;
    f32x2 S2[8];
#pragma unroll
    for (int j = 0; j < 8; ++j) S2[j] = (f32x2){0.f, 0.f};
    Raw4 Rq[2], Rk[2], Rv;
    auto gdn_load = [&](int tb) {
#pragma unroll
        for (int i = 0; i < 2; ++i) { const int it = tid + 512 * i, l = it >> 4, g8 = (it & 15) * 8;
          ld_taps(H + (size_t)(tb + l) * HP + C_GQKV + hh * 128 + g8, tb + l, Rq[i]); ld_taps(H + (size_t)(tb + l) * HP + C_GQKV + 512 + hh * 128 + g8, tb + l, Rk[i]); }
        { const int l = tid >> 3, g8 = (tid & 7) * 8; ld_taps(H + (size_t)(tb + l) * HP + C_GQKV + 1024 + hh * 128 + vh * 64 + g8, tb + l, Rv); }
    };
    gdn_load(0);
    __syncthreads();
#pragma unroll 1
    for (int c = 0; c < SEQ / 64; ++c) {
        const int t0 = c * 64;
#pragma unroll
        for (int i = 0; i < 2; ++i) { const int it = tid + 512 * i, l = it >> 4, g8 = (it & 15) * 8; float v[8]; float sq = 0.f;
          conv8_regs(Rq[i], wt, 320, g8, false, v);
#pragma unroll
          for (int j = 0; j < 8; ++j) sq += v[j] * v[j];
          sq = rsqrtf(red16(sq) + RMS_EPS) * 0.08838834764831845f;
#pragma unroll
          for (int j = 0; j < 8; ++j) v[j] *= sq;
          st8(qs + l * 128 + g8, v); sq = 0.f;
          conv8_regs(Rk[i], wt, 320, 128 + g8, false, v);
#pragma unroll
          for (int j = 0; j < 8; ++j) sq += v[j] * v[j];
          sq = rsqrtf(red16(sq) + RMS_EPS);
#pragma unroll
          for (int j = 0; j < 8; ++j) v[j] *= sq;
          st8(ks + l * 128 + g8, v); }
        { const int l = tid >> 3, g8 = (tid & 7) * 8; float v[8]; conv8_regs(Rv, wt, 320, 256 + g8, false, v); st8(vs + l * 64 + g8, v); }
        __syncthreads();
        if (c + 1 < SEQ / 64) gdn_load(t0 + 64);
#pragma unroll 1
        for (int l8 = 0; l8 < 64; l8 += 8) { float okeep = 0.f;
#pragma unroll
            for (int i = 0; i < 8; ++i) { const int l = l8 + i;
                const float eg = egs[t0 + l], bt = bts[t0 + l], vt = vs[l * 64 + vloc];
                const LAS float* kp = ks + l * 128 + 16 * part; const LAS float* qp = qs + l * 128 + 16 * part;
                f32x2 kv[8], u2 = {0.f, 0.f};
#pragma unroll
                for (int d4 = 0; d4 < 4; ++d4) { const f32x4 k4 = *(const LAS f32x4*)(kp + 4 * d4); kv[2 * d4] = (f32x2){k4[0], k4[1]}; kv[2 * d4 + 1] = (f32x2){k4[2], k4[3]}; }
#pragma unroll
                for (int d = 0; d < 8; ++d) u2 += kv[d] * S2[d];
                const float u = red8(u2[0] + u2[1]);
                const float w = bt * (vt - eg * u); const f32x2 w2 = {w, w}, eg2 = {eg, eg}; f32x2 o2 = {0.f, 0.f};
#pragma unroll
                for (int d4 = 0; d4 < 4; ++d4) { const f32x4 q4 = *(const LAS f32x4*)(qp + 4 * d4);
                    S2[2 * d4] = S2[2 * d4] * eg2 + kv[2 * d4] * w2; S2[2 * d4 + 1] = S2[2 * d4 + 1] * eg2 + kv[2 * d4 + 1] * w2;
                    o2 += (f32x2){q4[0], q4[1]} * S2[2 * d4]; o2 += (f32x2){q4[2], q4[3]} * S2[2 * d4 + 1]; }
                const float o = red8(o2[0] + o2[1]);
                okeep = (part == i) ? o : okeep; }
            ob[(l8 + part) * 64 + vloc] = okeep; }
        __syncthreads();
        { const int l = tid >> 3, g8 = (tid & 7) * 8; float o[8];
#pragma unroll
          for (int j = 0; j < 8; ++j) o[j] = ob[l * 64 + g8 + j];
          if (!dry) *(u32x4*)(GO + (size_t)(t0 + l) * 512 + hh * 128 + vh * 64 + g8) = pack8(o); }
        __syncthreads();
    }
}
__device__ __forceinline__ void gla_chain(const Params& p, int layer, int idx, LAS unsigned char* lds, bool dry) {
    const int tid = tid_(), bh = idx >> 1, vh = idx & 1, b = bh >> 2, hh = bh & 3;
    bf16_t* H = (bf16_t*)(p.ws + WS_BIG) + (size_t)b * SEQ * HP; const float* hs = (const float*)(p.ws + WS_HS) + (size_t)b * SEQ * HS;
    LAS float* qs = (LAS float*)lds;
    LAS float* ks = qs + 64 * 64;
    LAS float* es = ks + 64 * 64;
    LAS float* vs = es + 64 * 64;
    LAS float* ob = vs + 64 * 64;
    const int kk = tid & 63, seg = tid >> 6;
    float w2c[16];
#pragma unroll
    for (int r = 0; r < 16; ++r) w2c[r] = p.in[12][(size_t)layer * 16 * 256 + r * 256 + hh * 64 + kk];
    const float gb = p.in[13][layer * 256 + hh * 64 + kk];
    const int vloc = tid >> 3, part = tid & 7;
    f32x2 S2[4];
#pragma unroll
    for (int j = 0; j < 4; ++j) S2[j] = (f32x2){0.f, 0.f};
    const int vc0 = C_LQKV + 512 + hh * 128 + vh * 64;
#pragma unroll 1
    for (int c = 0; c < SEQ / 64; ++c) {
        const int t0 = c * 64;
        { const int l = tid >> 3, g8 = (tid & 7) * 8; float v[8];
          unpack8(*(const u32x4*)(H + (size_t)(t0 + l) * HP + C_LQKV + hh * 64 + g8), v);
#pragma unroll
          for (int j = 0; j < 8; ++j) v[j] *= 0.125f;
          st8(qs + l * 64 + g8, v);
          unpack8(*(const u32x4*)(H + (size_t)(t0 + l) * HP + C_LQKV + 256 + hh * 64 + g8), v); st8(ks + l * 64 + g8, v);
          unpack8(*(const u32x4*)(H + (size_t)(t0 + l) * HP + vc0 + g8), v); st8(vs + l * 64 + g8, v); }
#pragma unroll
        for (int i = 0; i < 8; ++i) { const int l = seg * 8 + i; const float* gl = hs + (size_t)(t0 + l) * HS + 24; float a = gb;
            const f32x4 g0 = *(const f32x4*)gl, g1 = *(const f32x4*)(gl + 4), g2 = *(const f32x4*)(gl + 8), g3 = *(const f32x4*)(gl + 12);
#pragma unroll
            for (int r = 0; r < 4; ++r) a += g0[r] * w2c[r] + g1[r] * w2c[4 + r] + g2[r] * w2c[8 + r] + g3[r] * w2c[12 + r];
            es[l * 64 + kk] = __expf(-softplusf_(-a) * 0.0625f); }
        __syncthreads();
#pragma unroll 1
        for (int l8 = 0; l8 < 64; l8 += 8) { float okeep = 0.f;
#pragma unroll
            for (int i = 0; i < 8; ++i) { const int l = l8 + i;
                const float vt = vs[l * 64 + vloc]; const f32x2 vt2 = {vt, vt}; f32x2 o2 = {0.f, 0.f};
#pragma unroll
                for (int d4 = 0; d4 < 2; ++d4) { const f32x4 qv = *(const LAS f32x4*)(qs + l * 64 + 8 * part + 4 * d4), kv = *(const LAS f32x4*)(ks + l * 64 + 8 * part + 4 * d4), ev = *(const LAS f32x4*)(es + l * 64 + 8 * part + 4 * d4);
                    S2[2 * d4] = S2[2 * d4] * (f32x2){ev[0], ev[1]} + (f32x2){kv[0], kv[1]} * vt2; S2[2 * d4 + 1] = S2[2 * d4 + 1] * (f32x2){ev[2], ev[3]} + (f32x2){kv[2], kv[3]} * vt2;
                    o2 += (f32x2){qv[0], qv[1]} * S2[2 * d4]; o2 += (f32x2){qv[2], qv[3]} * S2[2 * d4 + 1]; }
                const float o = red8(o2[0] + o2[1]);
                okeep = (part == i) ? o : okeep; }
            ob[(l8 + part) * 64 + vloc] = okeep; }
        __syncthreads();
        { const int l = tid >> 3, g8 = (tid & 7) * 8; float o[8];
#pragma unroll
          for (int j = 0; j < 8; ++j) o[j] = ob[l * 64 + g8 + j];
          if (!dry) *(u32x4*)(H + (size_t)(t0 + l) * HP + vc0 + g8) = pack8(o); }
        __syncthreads();
    }
}
__device__ __forceinline__ void phase_mixers(const Params& p, int layer, LAS unsigned char* lds, bool dry) {
    for (int role = blockIdx.x; role < 256; role += gridDim.x) {
        __syncthreads();
        if (role < 64) gdn_chain(p, layer, role, lds, dry);
        else if (role < 128) gla_chain(p, layer, role - 64, lds, dry);
        else ssd_chain(p, layer, role - 128, lds, dry);
    }
}
__device__ __forceinline__ void phase_finalize(const Params& p, int layer) {
    const int tid = tid_(), wid = tid >> 6, lane = tid & 63;
    bf16_t* H = (bf16_t*)(p.ws + WS_BIG);
    float nws[2][8], nwg[8], nwl[8];
#pragma unroll
    for (int j = 0; j < 8; ++j) { nws[0][j] = p.in[7][layer * 1024 + 8 * lane + j]; nws[1][j] = p.in[7][layer * 1024 + 512 + 8 * lane + j]; nwg[j] = p.in[11][layer * 128 + ((8 * lane + j) & 127)]; nwl[j] = p.in[14][layer * 128 + ((8 * lane + j) & 127)]; }
    for (int tok = blockIdx.x * 8 + wid; tok < MTOK; tok += gridDim.x * 8) {
        bf16_t* row = H + (size_t)tok * HP;
#pragma unroll
        for (int g = 0; g < 2; ++g) { float v[8]; unpack8(*(const u32x4*)(row + C_Z + 512 * g + 8 * lane), v); float s = 0.f;
#pragma unroll
            for (int j = 0; j < 8; ++j) s += v[j] * v[j];
#pragma unroll
            for (int o = 1; o < 64; o <<= 1) s += __shfl_xor(s, o);
            const float rs = rsqrtf(s * (1.f / 512.f) + RMS_EPS);
#pragma unroll
            for (int j = 0; j < 8; ++j) v[j] = v[j] * rs * nws[g][j];
            *(u32x4*)(row + C_Z + 512 * g + 8 * lane) = pack8(v); }
#pragma unroll
        for (int br = 0; br < 2; ++br) { const int craw = br == 0 ? C_GQKV : C_LQKV + 512, cgt = br == 0 ? C_GG : C_LR;
            float v[8], gt[8]; unpack8(br == 0 ? *(const u32x4*)((const bf16_t*)(p.ws + WS_GO) + (size_t)tok * 512 + 8 * lane) : *(const u32x4*)(row + craw + 8 * lane), v); unpack8(*(const u32x4*)(row + cgt + 8 * lane), gt); float s = 0.f;
#pragma unroll
            for (int j = 0; j < 8; ++j) s += v[j] * v[j];
#pragma unroll
            for (int o = 1; o < 16; o <<= 1) s += __shfl_xor(s, o);
            const float rs = rsqrtf(s * (1.f / 128.f) + RMS_EPS);
#pragma unroll
            for (int j = 0; j < 8; ++j) v[j] = v[j] * rs * (br == 0 ? nwg[j] : nwl[j]) * siluf_(gt[j]);
            *(u32x4*)(row + cgt + 8 * lane) = pack8(v); }
    }
}
__device__ __forceinline__ void phase_ln(const Params& p, const float* gam, const float* bet) {
    const int tid = tid_(), wid = tid >> 6, lane = tid & 63;
    float* X = p.out; bf16_t* xb = (bf16_t*)(p.ws + WS_XB);
    f32x4 gv[4], bv[4];
#pragma unroll
    for (int j = 0; j < 4; ++j) { gv[j] = *(const f32x4*)(gam + 256 * j + 4 * lane); bv[j] = *(const f32x4*)(bet + 256 * j + 4 * lane); }
    for (int row = blockIdx.x * 8 + wid; row < MTOK; row += gridDim.x * 8) {
        float* xr = X + (size_t)row * DM; f32x4 v[4]; float s = 0.f;
#pragma unroll
        for (int j = 0; j < 4; ++j) { v[j] = *(const f32x4*)(xr + 256 * j + 4 * lane); s += (v[j][0] + v[j][1]) + (v[j][2] + v[j][3]); }
#pragma unroll
        for (int o = 1; o < 64; o <<= 1) s += __shfl_xor(s, o);
        const float mean = s * (1.f / DM); float q = 0.f;
#pragma unroll
        for (int j = 0; j < 4; ++j) { v[j] = v[j] - mean; q += (v[j][0] * v[j][0] + v[j][1] * v[j][1]) + (v[j][2] * v[j][2] + v[j][3] * v[j][3]); }
#pragma unroll
        for (int o = 1; o < 64; o <<= 1) q += __shfl_xor(q, o);
        const float rstd = rsqrtf(q * (1.f / DM) + LN_EPS);
#pragma unroll
        for (int j = 0; j < 4; ++j) { const f32x4 o = v[j] * rstd * gv[j] + bv[j]; *(f32x4*)(xr + 256 * j + 4 * lane) = o;
            uint2 w; w.x = pk2(o[0], o[1]); w.y = pk2(o[2], o[3]); *(uint2*)(xb + (size_t)row * DM + 256 * j + 4 * lane) = w; }
    }
}
__device__ __forceinline__ void phase_convglu(const Params& p, int layer) {
    const int tid = tid_(), seg = tid >> 4, il = tid & 15;
    bf16_t* U = (bf16_t*)(p.ws + WS_BIG);
    const float* cw = p.in[22] + (size_t)layer * 3 * FF2; const float* cbp = p.in[23] + (size_t)layer * FF2;
    for (int w = blockIdx.x; w < NB * 22; w += gridDim.x) {
        const int b = w / 22, cgp = (w % 22) * 16 + il, c0 = cgp * 8;
        float wg[3][8], wu[3][8], bg[8], bu[8];
#pragma unroll
        for (int j = 0; j < 8; ++j) { bg[j] = cbp[c0 + j]; bu[j] = cbp[FF + c0 + j];
#pragma unroll
            for (int k = 0; k < 3; ++k) { wg[k][j] = cw[k * FF2 + c0 + j]; wu[k][j] = cw[k * FF2 + FF + c0 + j]; } }
        bf16_t* base = U + ((size_t)b * SEQ + seg * 64) * FF2 + c0;
        float g2[8], g1[8], u2[8], u1[8];
        if (seg > 0) { unpack8(*(const u32x4*)(base - 2 * (size_t)FF2), g2); unpack8(*(const u32x4*)(base - (size_t)FF2), g1); unpack8(*(const u32x4*)(base - 2 * (size_t)FF2 + FF), u2); unpack8(*(const u32x4*)(base - (size_t)FF2 + FF), u1); }
        else {
#pragma unroll
            for (int j = 0; j < 8; ++j) { g2[j] = 0.f; g1[j] = 0.f; u2[j] = 0.f; u1[j] = 0.f; } }
        __syncthreads();
#pragma unroll 4
        for (int r = 0; r < 64; ++r) { bf16_t* rp = base + (size_t)r * FF2; float gc[8], uc[8], o[8]; unpack8(*(const u32x4*)rp, gc); unpack8(*(const u32x4*)(rp + FF), uc);
#pragma unroll
            for (int j = 0; j < 8; ++j) { const float gg = wg[0][j] * g2[j] + wg[1][j] * g1[j] + wg[2][j] * gc[j] + bg[j], uu = wu[0][j] * u2[j] + wu[1][j] * u1[j] + wu[2][j] * uc[j] + bu[j];
                o[j] = siluf_(gg) * uu; g2[j] = g1[j]; g1[j] = gc[j]; u2[j] = u1[j]; u1[j] = uc[j]; }
            *(u32x4*)rp = pack8(o); }
        __syncthreads();
    }
}

#define XB_TMO      128
#define XB_XCNT(j)  (256  + 64 * (j))
#define XB_XSUB(j)  (1280 + 64 * (j))
#define XB_XGEN(j)  (2304 + 64 * (j))
#define XB_TOP      3328
#define XB_TOPGEN   3392
#define XCD_BAR_WORDS 3456
#define XB_SPIN_CAP (1u << 18)

__device__ __forceinline__ unsigned xb_ld(unsigned* p)              { return __hip_atomic_load(p, __ATOMIC_RELAXED, __HIP_MEMORY_SCOPE_AGENT); }
__device__ __forceinline__ unsigned xb_add(unsigned* p, unsigned v) { return __hip_atomic_fetch_add(p, v, __ATOMIC_RELAXED, __HIP_MEMORY_SCOPE_AGENT); }
__device__ __forceinline__ unsigned xb_xcc_id() { return (unsigned)__builtin_amdgcn_s_getreg((3 << 11) | 20) & 0xFu; }
#define XB_SPIN(cond, bar) do { unsigned _sp = 0; while (cond) { __builtin_amdgcn_s_sleep(1); \
    if ((++_sp & 255u) == 0u) { if (xb_ld(&(bar)[XB_TMO])) break; if (_sp > XB_SPIN_CAP) { atomicAdd(&(bar)[XB_TMO], 1u); break; } } } } while (0)

struct XcdBarrier {
    unsigned* bar; unsigned x;
    volatile LAS unsigned* st;
};

__device__ __forceinline__ XcdBarrier xcd_barrier_post(unsigned* bar, volatile LAS unsigned* st) {
    XcdBarrier b; b.bar = bar; b.x = xb_xcc_id(); b.st = st;
    if (threadIdx.x == 0) st[2] = xb_add(&bar[XB_XCNT(b.x)], 1u);
    return b;
}
__device__ __forceinline__ void xcd_barrier_complete(unsigned* bar, unsigned x, unsigned& nloc, unsigned& nx) {
    const unsigned G = gridDim.x * gridDim.y * gridDim.z;
    unsigned sum, cnt, mine, sp = 0u;
    for (;;) {
        sum = 0u; cnt = 0u; mine = 0u;
#pragma unroll
        for (unsigned j = 0; j < 16; ++j) { const unsigned c = xb_ld(&bar[XB_XCNT(j)]); sum += c; cnt += (c > 0u) ? 1u : 0u; mine = (j == x) ? c : mine; }
        if (sum == G) break;
        __builtin_amdgcn_s_sleep(1);
        if ((++sp & 255u) == 0u) { if (xb_ld(&bar[XB_TMO])) break; if (sp > XB_SPIN_CAP) { atomicAdd(&bar[XB_TMO], 1u); break; } }
    }
    nloc = mine > 0u ? mine : 1u; nx = cnt > 0u ? cnt : 1u;
}

__device__ __forceinline__ void xcd_barrier(const XcdBarrier& b) {
    asm volatile("s_waitcnt vmcnt(0)" ::: "memory");
    __syncthreads();
    if (threadIdx.x == 0) {
        unsigned* bar = b.bar;
        __builtin_amdgcn_s_waitcnt(0);
        unsigned nloc = b.st[0], nx = b.st[1];
        if (nloc == 0u) { xcd_barrier_complete(bar, b.x, nloc, nx); b.st[0] = nloc; b.st[1] = nx; }
        const unsigned old = xb_add(&bar[XB_XSUB(b.x)], 1u);
        const unsigned gen = old / nloc;
        if (old + 1u == (gen + 1u) * nloc) {
            __builtin_amdgcn_fence(__ATOMIC_RELEASE, "agent");
            asm volatile("s_waitcnt vmcnt(0)" ::: "memory");
            const unsigned og = xb_add(&bar[XB_TOP], 1u);
            const unsigned tg = og / nx;
            if (og + 1u == (tg + 1u) * nx) xb_add(&bar[XB_TOPGEN], 1u);
            else XB_SPIN(xb_ld(&bar[XB_TOPGEN]) == tg, bar);
            __builtin_amdgcn_fence(__ATOMIC_ACQUIRE, "agent");
            xb_add(&bar[XB_XGEN(b.x)], 1u);
            asm volatile("s_waitcnt vmcnt(0)" ::: "memory");
        } else {
            XB_SPIN(xb_ld(&bar[XB_XGEN(b.x)]) == gen, bar);
            __builtin_amdgcn_fence(__ATOMIC_ACQUIRE, "agent");
            asm volatile("s_waitcnt vmcnt(0)" ::: "memory");
        }
    }
    __syncthreads();
}


#ifndef ONLY
#define ONLY -1
#endif
#ifndef PROBE_SYNC
#define PROBE_SYNC 0
#endif
#ifndef PROBE_GEMM
#define PROBE_GEMM 0
#endif
#ifndef PROBE_SYNC
#define PROBE_SYNC 0
#endif
#ifndef PROBE_GEMM
#define PROBE_GEMM 0
#endif
#ifndef PROBE_MIX
#define PROBE_MIX 0
#endif
#ifndef DBG_SKIP
#define DBG_SKIP 0
#endif
#ifndef PHMASK
#define PHMASK 0xFFFF
#endif
#define PH(n) ((ONLY < 0 || ONLY == (n)) && ((PHMASK >> (n)) & 1))
__global__ void __launch_bounds__(512) mega_fwd(Params p) {
    extern __shared__ __attribute__((aligned(16))) unsigned char shm[];
    LAS unsigned char* lds = (LAS unsigned char*)shm;
    cg::grid_group grid = cg::this_grid();
    unsigned char* ws = p.ws;
    bf16_t* XB = (bf16_t*)(ws + WS_XB); bf16_t* H = (bf16_t*)(ws + WS_BIG);
    const bf16_t* W1 = (const bf16_t*)(ws + W_W1); const bf16_t* WG = (const bf16_t*)(ws + W_G);
    volatile LAS unsigned* xst = (volatile LAS unsigned*)(lds + LDS_BYTES - 16);
    if (threadIdx.x == 0) { xst[0] = 0u; xst[1] = 0u; xst[2] = 0u; xst[3] = blockIdx.x; }
    __syncthreads();
    const XcdBarrier xb = xcd_barrier_post((unsigned*)(ws + WS_BAR), xst);
    bf16_t* SG = H + C_XBC; bf16_t* MX = H + C_GQKV;
#if PROBE_SYNC
#pragma unroll 1
    for (int i = 0; i < 40; ++i) grid.sync();
#endif
#pragma unroll 1
    for (int layer = 0; layer < DEPTH; ++layer) {
#pragma unroll 1
        for (int st = 0; st < 16; ++st) {
            GJob j; bool isg = false, sync = true;
            j.A = XB; j.lda = DM; j.Bt = W1; j.ldb = DM; j.N = DM; j.K = DM; j.E.mode = 0; j.E.O = H; j.E.ldc = HP; j.E.Sg = SG; j.E.base = p.out; j.E.out = p.out;
            switch (st) {
            case 0: if (PH(0)) { phase_convert(p, layer, lds); if (layer == 0) phase_x_to_bf16(p); } break;
            case 1: isg = true; j.N = HP; break;
            case 2: if (PH(3)) {
#if PROBE_MIX
                phase_mixers(p, layer, lds, p.ws != nullptr); xcd_barrier(xb);
#endif
                phase_mixers(p, layer, lds, p.ws == nullptr); } break;
            case 3: if (PH(4)) phase_finalize(p, layer); break;
            case 4: isg = true; sync = false; j.Bt = WG; j.E.mode = 1; j.E.O = SG; break;
            case 5: isg = true; sync = false; j.A = H + C_Z; j.lda = HP; j.Bt = (const bf16_t*)(ws + W_PS); j.ldb = 1024; j.K = 1024; j.E.mode = 2; j.E.O = MX; break;
            case 6: isg = true; sync = false; j.Bt = WG + (size_t)1024 * 1024; j.E.mode = 1; j.E.O = SG; break;
            case 7: isg = true; sync = false; j.A = H + C_GG; j.lda = HP; j.Bt = (const bf16_t*)(ws + W_PG); j.ldb = 512; j.K = 512; j.E.mode = 3; j.E.O = MX; break;
            case 8: isg = true; sync = false; j.Bt = WG + (size_t)2048 * 1024; j.E.mode = 1; j.E.O = SG; break;
            case 9: isg = true; j.A = H + C_LR; j.lda = HP; j.Bt = (const bf16_t*)(ws + W_PL); j.ldb = 512; j.K = 512; j.E.mode = 3; j.E.O = MX; break;
            case 10: isg = true; j.A = MX; j.lda = HP; j.Bt = (const bf16_t*)(ws + W_O); j.E.mode = 4; j.E.base = layer == 0 ? p.in[0] : p.out; break;
            case 11: if (PH(7)) phase_ln(p, p.in[19] + layer * DM, p.in[20] + layer * DM); break;
            case 12: isg = true; j.Bt = (const bf16_t*)(ws + W_UP); j.N = FF2; j.E.ldc = FF2; break;
            case 13: if (PH(9)) phase_convglu(p, layer); break;
            case 14: isg = true; j.A = H; j.lda = FF2; j.Bt = (const bf16_t*)(ws + W_DN); j.ldb = FF; j.K = FF; j.E.mode = 4; break;
            default: if (PH(7)) phase_ln(p, p.in[25] + layer * DM, p.in[26] + layer * DM); break;
            }
            if ((DBG_SKIP & 1) && (st == 4 || st == 5)) isg = false;
            if ((DBG_SKIP & 2) && (st == 6 || st == 7)) isg = false;
            if ((DBG_SKIP & 4) && (st == 8 || st == 9)) isg = false;
            if (DBG_SKIP == 7 && st == 9) { isg = true; j.E.mode = 5; j.E.O = MX; }
            if ((DBG_SKIP & 1) && st == 7) j.E.mode = 2;
            if ((DBG_SKIP & 3) == 3 && st == 9) j.E.mode = 2;
            if (PH(1) && isg) run_gemm(lds, j, (int)xst[3]);
#if PROBE_GEMM
            if (isg && (st == 1 || st == 12)) { xcd_barrier(xb); run_gemm(lds, j, (int)xst[3]); }
#endif
#if PROBE_GEMM
            if (isg && (st == 1 || st == 12)) { xcd_barrier(xb); run_gemm(lds, j, (int)xst[3]); }
#endif
            if (st == 1 && PH(2)) phase_small(p);
            if (sync) { if (layer == 0 && st == 0) { grid.sync();
                    if (threadIdx.x == 0) {
                        bool ok = (gridDim.x & 7u) == 0u;
                        for (unsigned jx = 0; jx < 8; ++jx) ok = ok && (xb_ld(&xb.bar[XB_XCNT(jx)]) == gridDim.x / 8u);
                        xst[3] = (ok && xb.x < 8u) ? xst[2] * 8u + xb.x : blockIdx.x; }
                    __syncthreads(); }
                else xcd_barrier(xb); }
        }
    }
}

extern "C" void kernel_launch(void* const* d_in, const int* in_sizes, int n_in, void* d_out, int out_size, void* d_ws, size_t ws_size, hipStream_t stream) {
    static int grid_blocks = 0;
    if (grid_blocks == 0) {
        if (n_in != 27 || out_size != MTOK * DM || ws_size < WS_END) { fprintf(stderr, "kernel_launch: unexpected shapes (n_in %d out %d ws %zu need %zu)\n", n_in, out_size, ws_size, (size_t)WS_END); grid_blocks = -1; return; }
        int dev = 0, cus = 0, per_cu = 0;
        (void)hipGetDevice(&dev); (void)hipDeviceGetAttribute(&cus, hipDeviceAttributeMultiprocessorCount, dev);
        if (hipFuncSetAttribute((const void*)mega_fwd, hipFuncAttributeMaxDynamicSharedMemorySize, LDS_BYTES) != hipSuccess) { fprintf(stderr, "kernel_launch: hipFuncSetAttribute failed\n"); grid_blocks = -1; return; }
        if (hipOccupancyMaxActiveBlocksPerMultiprocessor(&per_cu, (const void*)mega_fwd, 512, LDS_BYTES) != hipSuccess || per_cu < 1) { fprintf(stderr, "kernel_launch: occupancy query failed (%d)\n", per_cu); grid_blocks = -1; return; }
        grid_blocks = cus * per_cu; if (grid_blocks > 256) grid_blocks = 256;
        fprintf(stderr, "kernel_launch: %d CUs x %d -> grid %d\n", cus, per_cu, grid_blocks);
    }
    if (grid_blocks < 0) return;
    if (hipMemsetAsync((unsigned char*)d_ws + WS_BAR, 0, XCD_BAR_WORDS * sizeof(unsigned), stream) != hipSuccess) { fprintf(stderr, "kernel_launch: memset of barrier words failed\n"); return; }
    Params p{};
    for (int i = 0; i < 27; ++i) p.in[i] = (const float*)d_in[i];
    p.out = (float*)d_out; p.ws = (unsigned char*)d_ws;
    void* args[] = {&p};
    hipError_t e = hipLaunchCooperativeKernel((const void*)mega_fwd, dim3(grid_blocks), dim3(512), args, LDS_BYTES, stream);
    if (e != hipSuccess) fprintf(stderr, "kernel_launch: cooperative launch failed: %s (grid %d)\n", hipGetErrorString(e), grid_blocks);
}
```

```cpp
#include <hip/hip_runtime.h>
#include <hip/hip_cooperative_groups.h>
#include <cstdio>
namespace cg = cooperative_groups;
__device__ __forceinline__ int tid_() { int t = threadIdx.x; asm volatile("" : "+v"(t)); return t; }

namespace pg8 {
#define PG8_LAS __attribute__((address_space(3)))
typedef unsigned short bf16_t;
typedef short bf16x8 __attribute__((ext_vector_type(8)));
typedef float f32x4 __attribute__((ext_vector_type(4)));
typedef unsigned u32x4 __attribute__((ext_vector_type(4)));
constexpr int BM = 256, BK = 64, HALF = 128, HTB = HALF * BK * 2  , STAGE_BYTES = 8 * HTB, NXCD = 8, WGM = 8;

__host__ __device__ __forceinline__ int lds_byte(int r, int c) { const int st = (r >> 4) * 2 + (c >> 5), rr = r & 15, cc = c & 31, ob = rr * 64 + cc * 2; return st * 1024 + (ob ^ (((ob >> 9) & 1) << 5)); }
__host__ __device__ __forceinline__ void stage_rc(int b, int& R, int& C) { const int st = b / 1024, sb = b % 1024, swz = sb ^ (((sb >> 9) & 1) << 5); R = (st >> 1) * 16 + swz / 64; C = (st & 1) * 32 + (swz % 64) / 2; }
__host__ __device__ __forceinline__ int perm32(int rho) { const int n = rho >> 4, i = rho & 15; return 8 * (i >> 2) + 4 * n + (i & 3); }

struct Unit { int pm, pn; };
struct Gemm { const bf16_t* A; const bf16_t* Bt; int M, N, K, lda, ldb; };

struct StaticOrder {
    int nM, nN, nwg, G, c;
    __host__ __device__ void init(int M, int N, int G_, int c_) { nM = M / BM; nN = N / BM; nwg = nM * nN; G = G_; c = c_; }
    __host__ __device__ bool next(int i, Unit& u) const {
        const long L = (long)i * G + c; if (L >= nwg) return false;
        int wgid = (int)L; { const int q = nwg / NXCD, r = nwg % NXCD, xcd = wgid % NXCD, off = wgid / NXCD; wgid = (xcd < r ? xcd * (q + 1) : r * (q + 1) + (xcd - r) * q) + off; }
        const int nig = WGM * nN, gid = wgid / nig, fm = gid * WGM, gsz = (nM - fm) < WGM ? (nM - fm) : WGM;
        u.pm = fm + ((wgid % nig) % gsz); u.pn = (wgid % nig) / gsz; return true;
    }
    __device__ __forceinline__ void a_ready(const Unit&) const {}
    __device__ __forceinline__ void done(const Unit&) const {}
};
__device__ __forceinline__ unsigned cvt_pk_bf16(float lo, float hi) { unsigned r; asm volatile("v_cvt_pk_bf16_f32 %0, %1, %2" : "=v"(r) : "v"(lo), "v"(hi)); return r; }
typedef float f32x2 __attribute__((ext_vector_type(2)));
template <class Epi, class Sched, bool STAMP = false>
__device__ __forceinline__ void gemm_phase(PG8_LAS unsigned char* lds, const Gemm g, const Sched& S, const Epi& E, unsigned long long* stamps) {
    const int tid = tid_(), wid = __builtin_amdgcn_readfirstlane(tid >> 6), lane = tid & 63, wr = wid >> 2, wc = wid & 3, fr = lane & 15, fq = lane >> 4;
    const int K = g.K, nt = K / BK;
    int ts_lo = 0, ts_hi = 0, nts = 0; const unsigned long long rt_entry = STAMP ? (unsigned long long)wall_clock64() : 0ull;
#define PG8_STAMP() do { if (STAMP && wid == 0 && nts < 64) { const unsigned long long _c = (unsigned long long)clock64(); \
        ts_lo = (lane == nts) ? (int)(unsigned)_c : ts_lo; ts_hi = (lane == nts) ? (int)(unsigned)(_c >> 32) : ts_hi; ++nts; } } while (0)
    PG8_STAMP();
    unsigned voffA[2], voffB[2];
#pragma unroll
    for (int i = 0; i < 2; ++i) { int R, C; stage_rc(tid * 16 + i * 8192, R, C); const int Rb = Epi::PERM ? ((R & ~31) + perm32(R & 31)) : R;
        voffA[i] = (unsigned)(R * g.lda + C) * 2u; voffB[i] = (unsigned)(Rb * g.ldb + C) * 2u; }
    const size_t kstep = (size_t)(BK * 2);
    const size_t hstepA = (size_t)HALF * g.lda * 2, hstepB = (size_t)HALF * g.ldb * 2;
    const size_t tstepA = 2 * hstepA, tstepB = 2 * hstepB;
    const unsigned ldsw = (unsigned)wid * 1024u;
    const int aoff = lds_byte(wr * 64 + fr, fq * 8), boff = lds_byte(wc * 32 + fr, fq * 8);
#define PG8_SA(b, h) (((b) * 2 + (h)) * HTB)
#define PG8_SB(b, h) ((4 + (b) * 2 + (h)) * HTB)
#define PG8_STAGE(bufoff, gbase, voff) do { _Pragma("unroll") for (int _i = 0; _i < 2; ++_i) \
        __builtin_amdgcn_global_load_lds((const unsigned*)((const char*)(gbase) + (voff)[_i]), (PG8_LAS unsigned*)(lds + (bufoff) + ldsw + _i * 8192), 16, 0, 0); } while (0)
#define PG8_LDA(dst, b, h) do { _Pragma("unroll") for (int m = 0; m < 4; ++m) _Pragma("unroll") for (int k = 0; k < 2; ++k) dst[m][k] = *(const PG8_LAS bf16x8*)(lds + PG8_SA(b, h) + aoff + m * 2048 + k * 1024); } while (0)
#define PG8_LDB(dst, b, h) do { _Pragma("unroll") for (int n = 0; n < 2; ++n) _Pragma("unroll") for (int k = 0; k < 2; ++k) dst[n][k] = *(const PG8_LAS bf16x8*)(lds + PG8_SB(b, h) + boff + n * 2048 + k * 1024); } while (0)
#define PG8_MMA(ai, bj, At, Bt) do { __builtin_amdgcn_s_setprio(1); _Pragma("unroll") for (int m = 0; m < 4; ++m) _Pragma("unroll") for (int n = 0; n < 2; ++n) _Pragma("unroll") for (int k = 0; k < 2; ++k) \
        acc[ai][bj][m][n] = __builtin_amdgcn_mfma_f32_16x16x32_bf16(Bt[n][k], At[m][k], acc[ai][bj][m][n], 0, 0, 0); __builtin_amdgcn_s_setprio(0); } while (0)
#define PG8_WAIT_V(n) asm volatile("s_waitcnt vmcnt(" #n ")" ::: "memory")
#define PG8_WAIT_L(n) asm volatile("s_waitcnt lgkmcnt(" #n ")" ::: "memory")
#define PG8_BAR __builtin_amdgcn_s_barrier()
#define PG8_SCHED __builtin_amdgcn_sched_barrier(0)
    Unit cur, nxt; int ui = 0;
    if (!S.next(0, cur)) return;
    f32x4 acc[2][2][4][2];
#pragma unroll
    for (int a = 0; a < 2; ++a)
#pragma unroll
        for (int b = 0; b < 2; ++b)
#pragma unroll
            for (int m = 0; m < 4; ++m)
#pragma unroll
                for (int n = 0; n < 2; ++n) acc[a][b][m][n] = (f32x4){0.f, 0.f, 0.f, 0.f};
    bf16x8 At[4][2], B0[2][2], B1[2][2];
    const char* cA = (const char*)g.A + (size_t)cur.pm * tstepA; const char* cB = (const char*)g.Bt + (size_t)cur.pn * tstepB;
    S.a_ready(cur);
    PG8_STAGE(PG8_SB(0, 0), cB, voffB); PG8_STAGE(PG8_SA(0, 0), cA, voffA); PG8_STAGE(PG8_SB(0, 1), cB + hstepB, voffB); PG8_STAGE(PG8_SA(0, 1), cA + hstepA, voffA);
    if (wr == 1) PG8_BAR;
    PG8_WAIT_V(4); PG8_BAR;
    PG8_STAGE(PG8_SB(1, 0), cB + kstep, voffB); PG8_STAGE(PG8_SA(1, 0), cA + kstep, voffA); PG8_STAGE(PG8_SB(1, 1), cB + hstepB + kstep, voffB);
    PG8_WAIT_V(6); PG8_BAR;
    PG8_STAMP();
    for (;;) {
        const bool has_next = S.next(ui + 1, nxt);
        const char* nA = has_next ? (const char*)g.A + (size_t)nxt.pm * tstepA : cA; const char* nB = has_next ? (const char*)g.Bt + (size_t)nxt.pn * tstepB : cB;
        for (int t = 0; t < nt; t += 2) {
            const bool last = (t == nt - 2);
            const char* a1 = cA + (size_t)(t + 1) * kstep;
            const char* a2 = last ? nA : cA + (size_t)(t + 2) * kstep; const char* b2 = last ? nB : cB + (size_t)(t + 2) * kstep;
            const char* a3 = a2 + kstep; const char* b3 = b2 + kstep;
            if (last && has_next) S.a_ready(nxt);
            PG8_LDB(B0, 0, 0); PG8_SCHED; PG8_LDA(At, 0, 0); PG8_STAGE(PG8_SA(1, 1), a1 + hstepA, voffA);
            PG8_WAIT_L(8); PG8_BAR; PG8_WAIT_L(0); PG8_MMA(0, 0, At, B0); PG8_BAR; PG8_SCHED;
            PG8_LDB(B1, 0, 1); PG8_STAGE(PG8_SB(0, 0), b2, voffB);
            PG8_BAR; PG8_WAIT_L(0); PG8_MMA(0, 1, At, B1); PG8_BAR;
            PG8_LDA(At, 0, 1); PG8_STAGE(PG8_SA(0, 0), a2, voffA);
            PG8_BAR; PG8_WAIT_L(0); PG8_MMA(1, 0, At, B0); PG8_BAR; PG8_SCHED;
            PG8_STAGE(PG8_SB(0, 1), b2 + hstepB, voffB);
            PG8_WAIT_V(6); PG8_BAR; PG8_MMA(1, 1, At, B1); PG8_BAR;
            PG8_LDB(B0, 1, 0); PG8_SCHED; PG8_LDA(At, 1, 0); PG8_STAGE(PG8_SA(0, 1), a2 + hstepA, voffA);
            PG8_WAIT_L(8); PG8_BAR; PG8_WAIT_L(0); PG8_MMA(0, 0, At, B0); PG8_BAR; PG8_SCHED;
            PG8_LDB(B1, 1, 1); PG8_STAGE(PG8_SB(1, 0), b3, voffB);
            PG8_BAR; PG8_WAIT_L(0); PG8_MMA(0, 1, At, B1); PG8_BAR;
            PG8_LDA(At, 1, 1); PG8_STAGE(PG8_SA(1, 0), a3, voffA);
            PG8_BAR; PG8_WAIT_L(0); PG8_MMA(1, 0, At, B0); PG8_BAR; PG8_SCHED;
            PG8_STAGE(PG8_SB(1, 1), b3 + hstepB, voffB);
            PG8_WAIT_V(6); PG8_BAR; PG8_MMA(1, 1, At, B1); PG8_BAR;
        }
        PG8_STAMP();
        if constexpr (!Epi::AFTER_DRAIN) { E(acc, cur, wr, wc, fr, fq); S.done(cur); }
        PG8_STAMP();
        if (!has_next) break;
#pragma unroll
        for (int a = 0; a < 2; ++a)
#pragma unroll
            for (int b = 0; b < 2; ++b)
#pragma unroll
                for (int m = 0; m < 4; ++m)
#pragma unroll
                    for (int n = 0; n < 2; ++n) acc[a][b][m][n] = (f32x4){0.f, 0.f, 0.f, 0.f};
        cur = nxt; cA = nA; cB = nB; ++ui;
    }
    PG8_WAIT_V(0);
    if (wr == 0) PG8_BAR;
    PG8_BAR;
    if constexpr (Epi::AFTER_DRAIN) { E.fused(acc, cur, wr, wc, fr, fq, lds, wid, lane); S.done(cur); }
    PG8_STAMP();
    if (STAMP && wid == 0) { stamps[lane] = lane < nts ? (((unsigned long long)(unsigned)ts_hi << 32) | (unsigned)ts_lo) : 0ull;
        if (lane == 62) stamps[62] = rt_entry; if (lane == 63) stamps[63] = (unsigned long long)wall_clock64(); }
#undef PG8_STAMP
#undef PG8_SA
#undef PG8_SB
#undef PG8_STAGE
#undef PG8_LDA
#undef PG8_LDB
#undef PG8_MMA
#undef PG8_WAIT_V
#undef PG8_WAIT_L
#undef PG8_BAR
#undef PG8_SCHED
}
}

using pg8::bf16_t; using pg8::bf16x8; using pg8::f32x4; using pg8::u32x4;
#define LAS __attribute__((address_space(3)))
constexpr int DM = 1024, NB = 8, SEQ = 2048, MTOK = NB * SEQ, DEPTH = 2, IN_DIM = 9256;
constexpr int HP = 6144;
constexpr int C_Z = 0, C_XBC = 1024, C_GQKV = 2560, C_GG = 4096, C_LQKV = 4608, C_LR = 5632;
constexpr int O_Z = 0, O_XBC = 1024, O_DT = 2560, O_GQKV = 2576, O_GA = 4112, O_GB = 4116, O_GG = 4120, O_LQKV = 4632, O_GLR = 5656, O_LR = 5672, O_GATES = 6184;
constexpr int HS = 64;
constexpr int FF = 2816, FF2 = 5632;
constexpr float ALPHA = 1.41421356237f, LN_EPS = 1e-5f, RMS_EPS = 1e-6f;
constexpr int LDS_BYTES = 160 * 1024;
constexpr size_t W_W1 = 0, W_SM = W_W1 + (size_t)6144 * 1024 * 2, W_G = W_SM + (size_t)64 * 1024 * 2, W_PS = W_G + (size_t)3072 * 1024 * 2, W_PG = W_PS + (size_t)1024 * 1024 * 2,
                 W_PL = W_PG + (size_t)1024 * 512 * 2, W_O = W_PL + (size_t)1024 * 512 * 2, W_UP = W_O + (size_t)1024 * 1024 * 2, W_DN = W_UP + (size_t)5632 * 1024 * 2,
                 WS_XB = W_DN + (size_t)1024 * 2816 * 2, WS_HS = WS_XB + (size_t)MTOK * 1024 * 2, WS_BIG = WS_HS + (size_t)MTOK * HS * 4, WS_GO = WS_BIG + (size_t)MTOK * HP * 2, WS_BAR = WS_GO + (size_t)MTOK * 512 * 2, WS_END = WS_BAR + 16384;

struct Params { const float* in[27]; float* out; unsigned char* ws; };

__device__ __forceinline__ float bf2f(bf16_t v) { return __uint_as_float(((unsigned)v) << 16); }
__device__ __forceinline__ bf16_t f2bf(float f) { unsigned u = __float_as_uint(f); u += 0x7FFFu + ((u >> 16) & 1u); return (bf16_t)(u >> 16); }
__device__ __forceinline__ unsigned pk2(float lo, float hi) { unsigned r; asm("v_cvt_pk_bf16_f32 %0, %1, %2" : "=v"(r) : "v"(lo), "v"(hi)); return r; }
__device__ __forceinline__ float sigmoidf_(float x) { return 1.0f / (1.0f + __expf(-x)); }
__device__ __forceinline__ float siluf_(float x) { return x / (1.0f + __expf(-x)); }
__device__ __forceinline__ float softplusf_(float x) { return x > 20.f ? x : log1pf(__expf(x)); }
__device__ __forceinline__ void unpack8(const u32x4 w, float (&f)[8]) {
    f[0] = __uint_as_float(w.x << 16); f[1] = __uint_as_float(w.x & 0xffff0000u); f[2] = __uint_as_float(w.y << 16); f[3] = __uint_as_float(w.y & 0xffff0000u);
    f[4] = __uint_as_float(w.z << 16); f[5] = __uint_as_float(w.z & 0xffff0000u); f[6] = __uint_as_float(w.w << 16); f[7] = __uint_as_float(w.w & 0xffff0000u); }
__device__ __forceinline__ u32x4 pack8(const float (&f)[8]) { u32x4 w; w.x = pk2(f[0], f[1]); w.y = pk2(f[2], f[3]); w.z = pk2(f[4], f[5]); w.w = pk2(f[6], f[7]); return w; }

struct EpiU {
    static constexpr bool PERM = true, AFTER_DRAIN = false;
    int mode; bf16_t* O; int ldc; const bf16_t* Sg; const float* base; float* out;
    __device__ __forceinline__ void operator()(const f32x4 (&acc)[2][2][4][2], const pg8::Unit& u, int wr, int wc, int fr, int fq) const {
        const int row0 = u.pm * 256 + wr * 64 + fr, col0 = u.pn * 256 + wc * 32 + 8 * fq;
#pragma unroll
        for (int ai = 0; ai < 2; ++ai)
#pragma unroll
            for (int m = 0; m < 4; ++m) { const int row = row0 + ai * 128 + m * 16;
#pragma unroll
                for (int bj = 0; bj < 2; ++bj) { f32x4 v0 = acc[ai][bj][m][0], v1 = acc[ai][bj][m][1];
                    if (mode == 4) { const size_t off = (size_t)row * DM + col0 + bj * 128;
                        const f32x4 b0 = *(const f32x4*)(base + off), b1 = *(const f32x4*)(base + off + 4);
                        *(f32x4*)(out + off) = b0 * ALPHA + v0; *(f32x4*)(out + off + 4) = b1 * ALPHA + v1;
                    } else { const size_t off = (size_t)row * ldc + col0 + bj * 128;
                        if (mode == 5) { v0 = (f32x4){0.f, 0.f, 0.f, 0.f}; v1 = v0; }
                        if (mode == 1) {
#pragma unroll
                            for (int j = 0; j < 4; ++j) { v0[j] = sigmoidf_(v0[j]); v1[j] = sigmoidf_(v1[j]); } }
                        if (mode >= 2) { float sg[8]; unpack8(*(const u32x4*)(Sg + off), sg);
#pragma unroll
                            for (int j = 0; j < 4; ++j) { v0[j] *= sg[j]; v1[j] *= sg[4 + j]; }
                            if (mode == 3) { float o[8]; unpack8(*(const u32x4*)(O + off), o);
#pragma unroll
                                for (int j = 0; j < 4; ++j) { v0[j] += o[j]; v1[j] += o[4 + j]; } } }
                        u32x4 w; w.x = pk2(v0[0], v0[1]); w.y = pk2(v0[2], v0[3]); w.z = pk2(v1[0], v1[1]); w.w = pk2(v1[2], v1[3]);
                        *(u32x4*)(O + off) = w; } }
                asm volatile("" ::: "memory"); }
    }
};
struct GJob { const bf16_t* A; int lda; const bf16_t* Bt; int ldb; int N, K; EpiU E; };
__device__ __forceinline__ void run_gemm(LAS unsigned char* lds, const GJob& j, int vwg) {
    pg8::Gemm g; g.A = j.A; g.Bt = j.Bt; g.M = MTOK; g.N = j.N; g.K = j.K; g.lda = j.lda; g.ldb = j.ldb;
    pg8::StaticOrder S; S.init(MTOK, j.N, (int)gridDim.x, vwg);
    pg8::gemm_phase<EpiU, pg8::StaticOrder, false>(lds, g, S, j.E, nullptr);
}
__device__ __forceinline__ void tr_item(const float* W, int ldw, int col0, int K, int ncols, bf16_t* WT, int row_off, LAS float* scr, int item, int lane) {
    const int nblk = ncols / 32, kb = item / nblk, nb = item % nblk, k0 = 64 * kb, n0 = 32 * nb;
#pragma unroll 8
    for (int i = 0; i < 32; ++i) { const int kk = 2 * i + (lane >> 5); scr[kk * 33 + (lane & 31)] = W[(size_t)(k0 + kk) * ldw + col0 + n0 + (lane & 31)]; }
    asm volatile("s_waitcnt lgkmcnt(0)" ::: "memory");
    const int c = lane & 7;
#pragma unroll
    for (int j = 0; j < 4; ++j) { const int n = (lane >> 3) + 8 * j; const LAS float* s = scr + (8 * c) * 33 + n;
        u32x4 o; o.x = pk2(s[0 * 33], s[1 * 33]); o.y = pk2(s[2 * 33], s[3 * 33]); o.z = pk2(s[4 * 33], s[5 * 33]); o.w = pk2(s[6 * 33], s[7 * 33]);
        *(u32x4*)(WT + (size_t)(row_off + n0 + n) * K + k0 + 8 * c) = o; }
    asm volatile("s_waitcnt lgkmcnt(0)" ::: "memory");
}
__device__ __forceinline__ void phase_convert(const Params& p, int layer, LAS unsigned char* lds) {
    const int tid = tid_(), wid = tid >> 6, lane = tid & 63;
    LAS float* scr = (LAS float*)(lds + wid * 16384);
    unsigned char* ws = p.ws;
    const float* w_in = p.in[1] + (size_t)layer * DM * IN_DIM;
    bf16_t* W1 = (bf16_t*)(ws + W_W1); bf16_t* WG = (bf16_t*)(ws + W_G);
    const int gw = blockIdx.x * 8 + wid, NGW = gridDim.x * 8;
#define JOB(src, ldw, col0, K, ncols, dst, rowoff) { const int ni = ((K) / 64) * ((ncols) / 32); if (r < ni) { tr_item(src, ldw, col0, K, ncols, dst, rowoff, scr, r, lane); continue; } r -= ni; }
    for (int it = gw; ; it += NGW) {
        int r = it;
        JOB(w_in, IN_DIM, O_Z, 1024, 1024, W1, C_Z)
        JOB(w_in, IN_DIM, O_XBC, 1024, 1536, W1, C_XBC)
        JOB(w_in, IN_DIM, O_GQKV, 1024, 1536, W1, C_GQKV)
        JOB(w_in, IN_DIM, O_GG, 1024, 512, W1, C_GG)
        JOB(w_in, IN_DIM, O_LQKV, 1024, 1024, W1, C_LQKV)
        JOB(w_in, IN_DIM, O_LR, 1024, 512, W1, C_LR)
        JOB(w_in, IN_DIM, O_GATES, 1024, 3072, WG, 0)
        JOB(p.in[15] + (size_t)layer * 1024 * 1024, 1024, 0, 1024, 1024, (bf16_t*)(ws + W_PS), 0)
        JOB(p.in[16] + (size_t)layer * 512 * 1024, 1024, 0, 512, 1024, (bf16_t*)(ws + W_PG), 0)
        JOB(p.in[17] + (size_t)layer * 512 * 1024, 1024, 0, 512, 1024, (bf16_t*)(ws + W_PL), 0)
        JOB(p.in[18] + (size_t)layer * 1024 * 1024, 1024, 0, 1024, 1024, (bf16_t*)(ws + W_O), 0)
        JOB(p.in[21] + (size_t)layer * 1024 * FF2, FF2, 0, 1024, FF2, (bf16_t*)(ws + W_UP), 0)
        JOB(p.in[24] + (size_t)layer * FF * 1024, 1024, 0, FF, 1024, (bf16_t*)(ws + W_DN), 0)
        break;
    }
#undef JOB
    bf16_t* WS = (bf16_t*)(ws + W_SM);
    for (int i = blockIdx.x * 512 + tid; i < 64 * 1024; i += gridDim.x * 512) {
        const int n = i >> 10, k = i & 1023; int oc = -1;
        if (n < 16) oc = O_DT + n; else if (n < 20) oc = O_GA + n - 16; else if (n < 24) oc = O_GB + n - 20; else if (n < 40) oc = O_GLR + n - 24;
        WS[i] = oc >= 0 ? f2bf(w_in[(size_t)k * IN_DIM + oc]) : (bf16_t)0;
    }
}
__device__ __forceinline__ void phase_x_to_bf16(const Params& p) {
    const float* x = p.in[0]; bf16_t* xb = (bf16_t*)(p.ws + WS_XB);
    for (size_t i = (size_t)blockIdx.x * 512 + tid_(); i < (size_t)MTOK * DM / 8; i += (size_t)gridDim.x * 512) {
        const f32x4 a = *(const f32x4*)(x + i * 8), b = *(const f32x4*)(x + i * 8 + 4);
        u32x4 w; w.x = pk2(a[0], a[1]); w.y = pk2(a[2], a[3]); w.z = pk2(b[0], b[1]); w.w = pk2(b[2], b[3]);
        *(u32x4*)(xb + i * 8) = w; }
}
__device__ __forceinline__ void phase_small(const Params& p) {
    const int tid = tid_(), wid = tid >> 6, lane = tid & 63, fr = lane & 15, fq = lane >> 4, mt = wid & 3, np = wid >> 2;
    const bf16_t* xb = (const bf16_t*)(p.ws + WS_XB); const bf16_t* WS = (const bf16_t*)(p.ws + W_SM); float* hs = (float*)(p.ws + WS_HS);
    for (int rb = blockIdx.x; rb < MTOK / 64; rb += gridDim.x) {
        const int r0 = rb * 64;
        f32x4 a0 = {0.f, 0.f, 0.f, 0.f}, a1 = {0.f, 0.f, 0.f, 0.f};
        const bf16_t* ap = xb + (size_t)(r0 + 16 * mt + fr) * 1024 + 8 * fq; const bf16_t* b0p = WS + (size_t)(32 * np + fr) * 1024 + 8 * fq; const bf16_t* b1p = b0p + 16 * 1024;
#pragma unroll 4
        for (int kk = 0; kk < 32; ++kk) { const bf16x8 a = *(const bf16x8*)(ap + kk * 32), b0 = *(const bf16x8*)(b0p + kk * 32), b1 = *(const bf16x8*)(b1p + kk * 32);
            a0 = __builtin_amdgcn_mfma_f32_16x16x32_bf16(a, b0, a0, 0, 0, 0); a1 = __builtin_amdgcn_mfma_f32_16x16x32_bf16(a, b1, a1, 0, 0, 0); }
#pragma unroll
        for (int j = 0; j < 4; ++j) { float* o = hs + (size_t)(r0 + 16 * mt + 4 * fq + j) * HS + 32 * np + fr; o[0] = a0[j]; o[16] = a1[j]; }
    }
}

__device__ __forceinline__ void conv8_silu(const bf16_t* gp, int t, const LAS float* wt, int nch, int c8, bool bias, float (&o)[8]) {
    float acc[8];
#pragma unroll
    for (int j = 0; j < 8; ++j) acc[j] = bias ? wt[4 * nch + c8 + j] : 0.f;
#pragma unroll
    for (int k = 0; k < 4; ++k) { const int tt = t - 3 + k;
        if (tt >= 0) { float xv[8]; unpack8(*(const u32x4*)(gp + (ptrdiff_t)(k - 3) * HP), xv); const f32x4 wa = *(const LAS f32x4*)(wt + k * nch + c8), wb = *(const LAS f32x4*)(wt + k * nch + c8 + 4);
#pragma unroll
            for (int j = 0; j < 4; ++j) { acc[j] += wa[j] * xv[j]; acc[4 + j] += wb[j] * xv[4 + j]; } } }
#pragma unroll
    for (int j = 0; j < 8; ++j) o[j] = siluf_(acc[j]);
}
typedef float f32x2 __attribute__((ext_vector_type(2)));
template <int CTRL> __device__ __forceinline__ float dpp_add(float v) { const int x = __builtin_amdgcn_update_dpp(0, __float_as_int(v), CTRL, 0xF, 0xF, true); return v + __int_as_float(x); }
__device__ __forceinline__ float red4(float v) { v = dpp_add<0xB1>(v); return dpp_add<0x4E>(v); }
__device__ __forceinline__ float red8(float v) { return dpp_add<0x141>(red4(v)); }
__device__ __forceinline__ float red16(float v) { return dpp_add<0x140>(red8(v)); }
struct Raw4 { u32x4 r[4]; };
__device__ __forceinline__ void ld_taps(const bf16_t* gp, int t, Raw4& R) {
#pragma unroll
    for (int k = 0; k < 4; ++k) { const int tt = t - 3 + k; R.r[k] = tt >= 0 ? *(const u32x4*)(gp + (ptrdiff_t)(k - 3) * HP) : (u32x4){0u, 0u, 0u, 0u}; }
}
__device__ __forceinline__ void conv8_regs(const Raw4& R, const LAS float* wt, int nch, int c8, bool bias, float (&o)[8]) {
    float acc[8];
#pragma unroll
    for (int j = 0; j < 8; ++j) acc[j] = bias ? wt[4 * nch + c8 + j] : 0.f;
#pragma unroll
    for (int k = 0; k < 4; ++k) { float xv[8]; unpack8(R.r[k], xv); const f32x4 wa = *(const LAS f32x4*)(wt + k * nch + c8), wb = *(const LAS f32x4*)(wt + k * nch + c8 + 4);
#pragma unroll
        for (int j = 0; j < 4; ++j) { acc[j] += wa[j] * xv[j]; acc[4 + j] += wb[j] * xv[4 + j]; } }
#pragma unroll
    for (int j = 0; j < 8; ++j) o[j] = siluf_(acc[j]);
}
__device__ __forceinline__ void st8(LAS float* d, const float (&v)[8]) { *(LAS f32x4*)d = (f32x4){v[0], v[1], v[2], v[3]}; *(LAS f32x4*)(d + 4) = (f32x4){v[4], v[5], v[6], v[7]}; }

__device__ __forceinline__ void ssd_chain(const Params& p, int layer, int idx, LAS unsigned char* lds, bool dry) {
    const int tid = tid_(), b = idx >> 4, head = idx & 15, grp = head >> 3;
    bf16_t* H = (bf16_t*)(p.ws + WS_BIG) + (size_t)b * SEQ * HP; const float* hs = (const float*)(p.ws + WS_HS) + (size_t)b * SEQ * HS;
    LAS float* dts = (LAS float*)lds;
    LAS float* wt  = (LAS float*)(lds + 8192);
    LAS float* xs  = (LAS float*)(lds + 16384);
    LAS float* zs  = xs + 64 * 64;
    LAS float* Bs  = zs + 64 * 64;
    LAS float* Cs  = Bs + 64 * 128;
    LAS float* dAs = Cs + 64 * 128;
    LAS float* dxs = dAs + 2048;
    LAS float* yb  = dxs + 64 * 64;
    const float A = -__expf(p.in[5][layer * 16 + head]), Dk = p.in[6][layer * 16 + head], dtb = p.in[4][layer * 16 + head];
    for (int t = tid; t < SEQ; t += 512) { const float d = softplusf_(hs[(size_t)t * HS + head] + dtb); dts[t] = d; dAs[t] = __expf(d * A); }
    if (tid < 320) { const int ch = tid < 64 ? head * 64 + tid : (tid < 192 ? 1024 + grp * 128 + (tid - 64) : 1280 + grp * 128 + (tid - 192));
        const float* cw = p.in[2] + (size_t)layer * 4 * 1536;
#pragma unroll
        for (int k = 0; k < 4; ++k) wt[k * 320 + tid] = cw[k * 1536 + ch];
        wt[4 * 320 + tid] = p.in[3][layer * 1536 + ch]; }
    const int pp = tid >> 3, ns = tid & 7;
    f32x2 h2[8];
#pragma unroll
    for (int j = 0; j < 8; ++j) h2[j] = (f32x2){0.f, 0.f};
    Raw4 Rx, RB[2], RC[2]; u32x4 Rz;
    auto ssd_load = [&](int tb) {
        { const int l = tid >> 3, g8 = (tid & 7) * 8; ld_taps(H + (size_t)(tb + l) * HP + C_XBC + head * 64 + g8, tb + l, Rx); Rz = *(const u32x4*)(H + (size_t)(tb + l) * HP + C_Z + head * 64 + g8); }
#pragma unroll
        for (int i = 0; i < 2; ++i) { const int it = tid + 512 * i, l = it >> 4, g8 = (it & 15) * 8;
          ld_taps(H + (size_t)(tb + l) * HP + C_XBC + 1024 + grp * 128 + g8, tb + l, RB[i]); ld_taps(H + (size_t)(tb + l) * HP + C_XBC + 1280 + grp * 128 + g8, tb + l, RC[i]); }
    };
    ssd_load(0);
    __syncthreads();
#pragma unroll 1
    for (int c = 0; c < SEQ / 64; ++c) {
        const int t0 = c * 64;
        { const int l = tid >> 3, g8 = (tid & 7) * 8; float v[8];
          conv8_regs(Rx, wt, 320, g8, true, v); st8(xs + l * 64 + g8, v);
          { const float d = dts[t0 + l]; float dv[8];
#pragma unroll
            for (int j = 0; j < 8; ++j) dv[j] = d * v[j];
            st8(dxs + l * 64 + g8, dv); }
          unpack8(Rz, v); st8(zs + l * 64 + g8, v); }
#pragma unroll
        for (int i = 0; i < 2; ++i) { const int it = tid + 512 * i, l = it >> 4, g8 = (it & 15) * 8; float v[8];
          conv8_regs(RB[i], wt, 320, 64 + g8, true, v); st8(Bs + l * 128 + g8, v);
          conv8_regs(RC[i], wt, 320, 192 + g8, true, v); st8(Cs + l * 128 + g8, v); }
        __syncthreads();
        if (c + 1 < SEQ / 64) ssd_load(t0 + 64);
#pragma unroll 1
        for (int l8 = 0; l8 < 64; l8 += 8) { float ykeep = 0.f;
#pragma unroll
            for (int i = 0; i < 8; ++i) { const int l = l8 + i;
                const float dA = dAs[t0 + l], dx = dxs[l * 64 + pp]; const f32x2 dA2 = {dA, dA}, dx2 = {dx, dx}; f32x2 y2 = {0.f, 0.f};
#pragma unroll
                for (int j4 = 0; j4 < 4; ++j4) { const f32x4 Bv = *(const LAS f32x4*)(Bs + l * 128 + 16 * ns + 4 * j4), Cv = *(const LAS f32x4*)(Cs + l * 128 + 16 * ns + 4 * j4);
                    h2[2 * j4] = h2[2 * j4] * dA2 + dx2 * (f32x2){Bv[0], Bv[1]}; h2[2 * j4 + 1] = h2[2 * j4 + 1] * dA2 + dx2 * (f32x2){Bv[2], Bv[3]};
                    y2 += (f32x2){Cv[0], Cv[1]} * h2[2 * j4]; y2 += (f32x2){Cv[2], Cv[3]} * h2[2 * j4 + 1]; }
                const float y = red8(y2[0] + y2[1]);
                ykeep = (ns == i) ? y : ykeep; }
            yb[(l8 + ns) * 64 + pp] = ykeep; }
        __syncthreads();
        { const int l = tid >> 3, g8 = (tid & 7) * 8; float o[8];
#pragma unroll
          for (int j = 0; j < 8; ++j) o[j] = (yb[l * 64 + g8 + j] + Dk * xs[l * 64 + g8 + j]) * siluf_(zs[l * 64 + g8 + j]);
          if (!dry) *(u32x4*)(H + (size_t)(t0 + l) * HP + C_Z + head * 64 + g8) = pack8(o); }
        __syncthreads();
    }
}
__device__ __forceinline__ void gdn_chain(const Params& p, int layer, int idx, LAS unsigned char* lds, bool dry) {
    const int tid = tid_(), bh = idx >> 1, vh = idx & 1, b = bh >> 2, hh = bh & 3;
    const bf16_t* H = (const bf16_t*)(p.ws + WS_BIG) + (size_t)b * SEQ * HP; const float* hs = (const float*)(p.ws + WS_HS) + (size_t)b * SEQ * HS;
    bf16_t* GO = (bf16_t*)(p.ws + WS_GO) + (size_t)b * SEQ * 512;
    LAS float* egs = (LAS float*)lds;
    LAS float* bts = egs + 2048;
    LAS float* wt  = bts + 2048;
    LAS float* qs  = wt + 4 * 320;
    LAS float* ks  = qs + 64 * 128;
    LAS float* vs  = ks + 64 * 128;
    LAS float* ob  = vs + 64 * 64;
    const float An = -__expf(p.in[9][layer * 4 + hh]), dtb = p.in[10][layer * 4 + hh];
    for (int t = tid; t < SEQ; t += 512) { egs[t] = __expf(An * softplusf_(hs[(size_t)t * HS + 16 + hh] + dtb)); bts[t] = sigmoidf_(hs[(size_t)t * HS + 20 + hh]); }
    if (tid < 320) { const int ch = tid < 128 ? hh * 128 + tid : (tid < 256 ? 512 + hh * 128 + (tid - 128) : 1024 + hh * 128 + vh * 64 + (tid - 256));
        const float* cw = p.in[8] + (size_t)layer * 4 * 1536;
#pragma unroll
        for (int k = 0; k < 4; ++k) wt[k * 320 + tid] = cw[k * 1536 + ch]; }
    const int vloc = tid >> 3, part = tid & 7;
    f32x2 S2[8];
#pragma unroll
    for (int j = 0; j < 8; ++j) S2[j] = (f32x2){0.f, 0.f};
    Raw4 Rq[2], Rk[2], Rv;
    auto gdn_load = [&](int tb) {
#pragma unroll
        for (int i = 0; i < 2; ++i) { const int it = tid + 512 * i, l = it >> 4, g8 = (it & 15) * 8;
          ld_taps(H + (size_t)(tb + l) * HP + C_GQKV + hh * 128 + g8, tb + l, Rq[i]); ld_taps(H + (size_t)(tb + l) * HP + C_GQKV + 512 + hh * 128 + g8, tb + l, Rk[i]); }
        { const int l = tid >> 3, g8 = (tid & 7) * 8; ld_taps(H + (size_t)(tb + l) * HP + C_GQKV + 1024 + hh * 128 + vh * 64 + g8, tb + l, Rv); }
    };
    gdn_load(0);
    __syncthreads();
#pragma unroll 1
    for (int c = 0; c < SEQ / 64; ++c) {
        const int t0 = c * 64;
#pragma unroll
        for (int i = 0; i < 2; ++i) { const int it = tid + 512 * i, l = it >> 4, g8 = (it & 15) * 8; float v[8]; float sq = 0.f;
          conv8_regs(Rq[i], wt, 320, g8, false, v);
#pragma unroll
          for (int j = 0; j < 8; ++j) sq += v[j] * v[j];
          sq = rsqrtf(red16(sq) + RMS_EPS) * 0.08838834764831845f;
#pragma unroll
          for (int j = 0; j < 8; ++j) v[j] *= sq;
          st8(qs + l * 128 + g8, v); sq = 0.f;
          conv8_regs(Rk[i], wt, 320, 128 + g8, false, v);
#pragma unroll
          for (int j = 0; j < 8; ++j) sq += v[j] * v[j];
          sq = rsqrtf(red16(sq) + RMS_EPS);
#pragma unroll
          for (int j = 0; j < 8; ++j) v[j] *= sq;
          st8(ks + l * 128 + g8, v); }
        { const int l = tid >> 3, g8 = (tid & 7) * 8; float v[8]; conv8_regs(Rv, wt, 320, 256 + g8, false, v); st8(vs + l * 64 + g8, v); }
        __syncthreads();
        if (c + 1 < SEQ / 64) gdn_load(t0 + 64);
#pragma unroll 1
        for (int l8 = 0; l8 < 64; l8 += 8) { float okeep = 0.f;
#pragma unroll
            for (int i = 0; i < 8; ++i) { const int l = l8 + i;
                const float eg = egs[t0 + l], bt = bts[t0 + l], vt = vs[l * 64 + vloc];
                const LAS float* kp = ks + l * 128 + 16 * part; const LAS float* qp = qs + l * 128 + 16 * part;
                f32x2 kv[8], u2 = {0.f, 0.f};
#pragma unroll
                for (int d4 = 0; d4 < 4; ++d4) { const f32x4 k4 = *(const LAS f32x4*)(kp + 4 * d4); kv[2 * d4] = (f32x2){k4[0], k4[1]}; kv[2 * d4 + 1] = (f32x2){k4[2], k4[3]}; }
#pragma unroll
                for (int d = 0; d < 8; ++d) u2 += kv[d] * S2[d];
                const float u = red8(u2[0] + u2[1]);
                const float w = bt * (vt - eg * u); const f32x2 w2 = {w, w}, eg2 = {eg, eg}; f32x2 o2 = {0.f, 0.f};
#pragma unroll
                for (int d4 = 0; d4 < 4; ++d4) { const f32x4 q4 = *(const LAS f32x4*)(qp + 4 * d4);
                    S2[2 * d4] = S2[2 * d4] * eg2 + kv[2 * d4] * w2; S2[2 * d4 + 1] = S2[2 * d4 + 1] * eg2 + kv[2 * d4 + 1] * w2;
                    o2 += (f32x2){q4[0], q4[1]} * S2[2 * d4]; o2 += (f32x2){q4[2], q4[3]} * S2[2 * d4 + 1]; }
                const float o = red8(o2[0] + o2[1]);
                okeep = (part == i) ? o : okeep; }
            ob[(l8 + part) * 64 + vloc] = okeep; }
        __syncthreads();
        { const int l = tid >> 3, g8 = (tid & 7) * 8; float o[8];
#pragma unroll
          for (int j = 0; j < 8; ++j) o[j] = ob[l * 64 + g8 + j];
          if (!dry) *(u32x4*)(GO + (size_t)(t0 + l) * 512 + hh * 128 + vh * 64 + g8) = pack8(o); }
        __syncthreads();
    }
}
__device__ __forceinline__ void gla_chain(const Params& p, int layer, int idx, LAS unsigned char* lds, bool dry) {
    const int tid = tid_(), bh = idx >> 1, vh = idx & 1, b = bh >> 2, hh = bh & 3;
    bf16_t* H = (bf16_t*)(p.ws + WS_BIG) + (size_t)b * SEQ * HP; const float* hs = (const float*)(p.ws + WS_HS) + (size_t)b * SEQ * HS;
    LAS float* qs = (LAS float*)lds;
    LAS float* ks = qs + 64 * 64;
    LAS float* es = ks + 64 * 64;
    LAS float* vs = es + 64 * 64;
    LAS float* ob = vs + 64 * 64;
    const int kk = tid & 63, seg = tid >> 6;
    float w2c[16];
#pragma unroll
    for (int r = 0; r < 16; ++r) w2c[r] = p.in[12][(size_t)layer * 16 * 256 + r * 256 + hh * 64 + kk];
    const float gb = p.in[13][layer * 256 + hh * 64 + kk];
    const int vloc = tid >> 3, part = tid & 7;
    f32x2 S2[4];
#pragma unroll
    for (int j = 0; j < 4; ++j) S2[j] = (f32x2){0.f, 0.f};
    const int vc0 = C_LQKV + 512 + hh * 128 + vh * 64;
#pragma unroll 1
    for (int c = 0; c < SEQ / 64; ++c) {
        const int t0 = c * 64;
        { const int l = tid >> 3, g8 = (tid & 7) * 8; float v[8];
          unpack8(*(const u32x4*)(H + (size_t)(t0 + l) * HP + C_LQKV + hh * 64 + g8), v);
#pragma unroll
          for (int j = 0; j < 8; ++j) v[j] *= 0.125f;
          st8(qs + l * 64 + g8, v);
          unpack8(*(const u32x4*)(H + (size_t)(t0 + l) * HP + C_LQKV + 256 + hh * 64 + g8), v); st8(ks + l * 64 + g8, v);
          unpack8(*(const u32x4*)(H + (size_t)(t0 + l) * HP + vc0 + g8), v); st8(vs + l * 64 + g8, v); }
#pragma unroll
        for (int i = 0; i < 8; ++i) { const int l = seg * 8 + i; const float* gl = hs + (size_t)(t0 + l) * HS + 24; float a = gb;
            const f32x4 g0 = *(const f32x4*)gl, g1 = *(const f32x4*)(gl + 4), g2 = *(const f32x4*)(gl + 8), g3 = *(const f32x4*)(gl + 12);
#pragma unroll
            for (int r = 0; r < 4; ++r) a += g0[r] * w2c[r] + g1[r] * w2c[4 + r] + g2[r] * w2c[8 + r] + g3[r] * w2c[12 + r];
            es[l * 64 + kk] = __expf(-softplusf_(-a) * 0.0625f); }
        __syncthreads();
#pragma unroll 1
        for (int l8 = 0; l8 < 64; l8 += 8) { float okeep = 0.f;
#pragma unroll
            for (int i = 0; i < 8; ++i) { const int l = l8 + i;
                const float vt = vs[l * 64 + vloc]; const f32x2 vt2 = {vt, vt}; f32x2 o2 = {0.f, 0.f};
#pragma unroll
                for (int d4 = 0; d4 < 2; ++d4) { const f32x4 qv = *(const LAS f32x4*)(qs + l * 64 + 8 * part + 4 * d4), kv = *(const LAS f32x4*)(ks + l * 64 + 8 * part + 4 * d4), ev = *(const LAS f32x4*)(es + l * 64 + 8 * part + 4 * d4);
                    S2[2 * d4] = S2[2 * d4] * (f32x2){ev[0], ev[1]} + (f32x2){kv[0], kv[1]} * vt2; S2[2 * d4 + 1] = S2[2 * d4 + 1] * (f32x2){ev[2], ev[3]} + (f32x2){kv[2], kv[3]} * vt2;
                    o2 += (f32x2){qv[0], qv[1]} * S2[2 * d4]; o2 += (f32x2){qv[2], qv[3]} * S2[2 * d4 + 1]; }
                const float o = red8(o2[0] + o2[1]);
                okeep = (part == i) ? o : okeep; }
            ob[(l8 + part) * 64 + vloc] = okeep; }
        __syncthreads();
        { const int l = tid >> 3, g8 = (tid & 7) * 8; float o[8];
#pragma unroll
          for (int j = 0; j < 8; ++j) o[j] = ob[l * 64 + g8 + j];
          if (!dry) *(u32x4*)(H + (size_t)(t0 + l) * HP + vc0 + g8) = pack8(o); }
        __syncthreads();
    }
}
template <int K> __device__ __forceinline__ f32x4 mm16(const LAS bf16_t* A, int pa, const LAS bf16_t* B, int pb, f32x4 acc, int fr, int fq) {
#pragma unroll
    for (int k0 = 0; k0 < K; k0 += 32) {
        const bf16x8 a = *(const LAS bf16x8*)(A + fr * pa + k0 + 8 * fq);
        const bf16x8 b = *(const LAS bf16x8*)(B + fr * pb + k0 + 8 * fq);
        acc = __builtin_amdgcn_mfma_f32_16x16x32_bf16(a, b, acc, 0, 0, 0);
    }
    return acc;
}
__device__ __forceinline__ void gla_chunked(const Params& p, int layer, int idx, LAS unsigned char* lds, bool dry) {
    const int tid = tid_(), lane = tid & 63, wid = tid >> 6, fr = lane & 15, fq = lane >> 4, b = idx >> 2, hh = idx & 3;
    bf16_t* H = (bf16_t*)(p.ws + WS_BIG) + (size_t)b * SEQ * HP; const float* hs = (const float*)(p.ws + WS_HS) + (size_t)b * SEQ * HS;
    constexpr int P = 72;
    LAS bf16_t* QE  = (LAS bf16_t*)lds;
    LAS bf16_t* KE  = QE + 64 * P;
    LAS bf16_t* KDT = KE + 64 * P;
    LAS bf16_t* AM  = KDT + 64 * P;
    LAS bf16_t* VT  = AM + 64 * P;
    LAS bf16_t* ST  = VT + 128 * P;
    LAS float* segtot = (LAS float*)(ST + 128 * P);
    LAS float* cdv = segtot + 512;
    const int kk = tid & 63, seg = tid >> 6;
    float w2c[16];
#pragma unroll
    for (int r = 0; r < 16; ++r) w2c[r] = p.in[12][(size_t)layer * 16 * 256 + r * 256 + hh * 64 + kk];
    const float gb = p.in[13][layer * 256 + hh * 64 + kk];
    for (int i = tid; i < 128 * P; i += 512) ST[i] = (bf16_t)0;
    f32x4 Sacc[4];
#pragma unroll
    for (int j = 0; j < 4; ++j) Sacc[j] = (f32x4){0.f, 0.f, 0.f, 0.f};
    const int qc = C_LQKV + hh * 64 + kk, vc = C_LQKV + 512 + hh * 128;
#pragma unroll 1
    for (int c = 0; c < SEQ / 64; ++c) {
        const int t0 = c * 64;
        float gkp[8], qr[8], kr[8], run = 0.f;
#pragma unroll
        for (int i = 0; i < 8; ++i) { const int l = seg * 8 + i; const float* gl = hs + (size_t)(t0 + l) * HS + 24; float a = gb;
            const f32x4 g0 = *(const f32x4*)gl, g1 = *(const f32x4*)(gl + 4), g2 = *(const f32x4*)(gl + 8), g3 = *(const f32x4*)(gl + 12);
#pragma unroll
            for (int r = 0; r < 4; ++r) a += g0[r] * w2c[r] + g1[r] * w2c[4 + r] + g2[r] * w2c[8 + r] + g3[r] * w2c[12 + r];
            run += -softplusf_(-a) * 0.0625f; gkp[i] = run;
            qr[i] = bf2f(H[(size_t)(t0 + l) * HP + qc]); kr[i] = bf2f(H[(size_t)(t0 + l) * HP + qc + 256]); }
        segtot[seg * 64 + kk] = run;
        __syncthreads();
        float off = 0.f, tot = 0.f;
#pragma unroll
        for (int s8 = 0; s8 < 8; ++s8) { const float v = segtot[s8 * 64 + kk]; tot += v; off += (s8 < seg) ? v : 0.f; }
#pragma unroll
        for (int i = 0; i < 8; ++i) { const int l = seg * 8 + i; const float bc = off + gkp[i];
            QE[l * P + kk] = f2bf(qr[i] * 0.125f * __expf(bc)); KE[l * P + kk] = f2bf(kr[i] * __expf(-bc)); KDT[kk * P + l] = f2bf(kr[i] * __expf(tot - bc)); }
        if (seg == 0) cdv[kk] = __expf(tot);
#pragma unroll
        for (int i = 0; i < 2; ++i) { const int it = tid + 512 * i, l = it >> 4, g8 = (it & 15) * 8;
            const u32x4 w = *(const u32x4*)(H + (size_t)(t0 + l) * HP + vc + g8);
            VT[(g8 + 0) * P + l] = (bf16_t)(w.x & 0xffffu); VT[(g8 + 1) * P + l] = (bf16_t)(w.x >> 16); VT[(g8 + 2) * P + l] = (bf16_t)(w.y & 0xffffu); VT[(g8 + 3) * P + l] = (bf16_t)(w.y >> 16);
            VT[(g8 + 4) * P + l] = (bf16_t)(w.z & 0xffffu); VT[(g8 + 5) * P + l] = (bf16_t)(w.z >> 16); VT[(g8 + 6) * P + l] = (bf16_t)(w.w & 0xffffu); VT[(g8 + 7) * P + l] = (bf16_t)(w.w >> 16); }
        __syncthreads();
        { const int mt = wid >> 1;
#pragma unroll
          for (int n2 = 0; n2 < 2; ++n2) { const int nt = (wid & 1) * 2 + n2; f32x4 acc = {0.f, 0.f, 0.f, 0.f};
            if (nt <= mt) acc = mm16<64>(QE + 16 * mt * P, P, KE + 16 * nt * P, P, acc, fr, fq);
#pragma unroll
            for (int j = 0; j < 4; ++j) { const int l = 16 * mt + 4 * fq + j, s = 16 * nt + fr; AM[l * P + s] = f2bf(s <= l ? acc[j] : 0.f); } } }
        __syncthreads();
        { const int mt = wid & 3, ntb = (wid >> 2) * 4;
#pragma unroll
          for (int n4 = 0; n4 < 4; ++n4) { const int nt = ntb + n4; f32x4 acc = {0.f, 0.f, 0.f, 0.f};
            acc = mm16<64>(AM + 16 * mt * P, P, VT + 16 * nt * P, P, acc, fr, fq);
            acc = mm16<64>(QE + 16 * mt * P, P, ST + 16 * nt * P, P, acc, fr, fq);
            if (!dry) {
#pragma unroll
                for (int j = 0; j < 4; ++j) H[(size_t)(t0 + 16 * mt + 4 * fq + j) * HP + vc + 16 * nt + fr] = f2bf(acc[j]); } } }
#pragma unroll
        for (int kt = 0; kt < 4; ++kt) { const float cd = cdv[16 * kt + fr]; Sacc[kt] = Sacc[kt] * cd; Sacc[kt] = mm16<64>(VT + 16 * wid * P, P, KDT + 16 * kt * P, P, Sacc[kt], fr, fq); }
        __syncthreads();
#pragma unroll
        for (int kt = 0; kt < 4; ++kt)
#pragma unroll
            for (int j = 0; j < 4; ++j) ST[(16 * wid + 4 * fq + j) * P + 16 * kt + fr] = f2bf(Sacc[kt][j]);
    }
}
__device__ __forceinline__ void ssd_chunked(const Params& p, int layer, int idx, LAS unsigned char* lds, bool dry) {
    const int tid = tid_(), lane = tid & 63, wid = tid >> 6, fr = lane & 15, fq = lane >> 4, b = idx >> 4, head = idx & 15, grp = head >> 3;
    bf16_t* H = (bf16_t*)(p.ws + WS_BIG) + (size_t)b * SEQ * HP; const float* hs = (const float*)(p.ws + WS_HS) + (size_t)b * SEQ * HS;
    constexpr int PN = 136, PL = 72;
    LAS float* dts = (LAS float*)lds;
    LAS float* wt  = dts + 2048;
    LAS float* zs  = wt + 1600;
    LAS float* acs = zs + 64 * 64;
    LAS float* dtv = acs + 64;
    LAS bf16_t* Cm  = (LAS bf16_t*)(dtv + 64);
    LAS bf16_t* Bm  = Cm + 64 * PN;
    LAS bf16_t* SL  = Bm + 64 * PN;
    LAS bf16_t* BmT = SL + 64 * PN;
    LAS bf16_t* XT  = BmT + 128 * PL;
    LAS bf16_t* XwT = XT + 64 * PL;
    LAS bf16_t* WM  = XwT + 64 * PL;
    const float A = -__expf(p.in[5][layer * 16 + head]), Dk = p.in[6][layer * 16 + head], dtb = p.in[4][layer * 16 + head];
    for (int t = tid; t < SEQ; t += 512) dts[t] = softplusf_(hs[(size_t)t * HS + head] + dtb);
    if (tid < 320) { const int ch = tid < 64 ? head * 64 + tid : (tid < 192 ? 1024 + grp * 128 + (tid - 64) : 1280 + grp * 128 + (tid - 192));
        const float* cw = p.in[2] + (size_t)layer * 4 * 1536;
#pragma unroll
        for (int k = 0; k < 4; ++k) wt[k * 320 + tid] = cw[k * 1536 + ch];
        wt[4 * 320 + tid] = p.in[3][layer * 1536 + ch]; }
    for (int i = tid; i < 64 * PN; i += 512) SL[i] = (bf16_t)0;
    f32x4 Sacc[4];
#pragma unroll
    for (int j = 0; j < 4; ++j) Sacc[j] = (f32x4){0.f, 0.f, 0.f, 0.f};
    Raw4 Rx, RB[2], RC[2]; u32x4 Rz;
    auto ssd_load = [&](int tb) {
        { const int l = tid >> 3, g8 = (tid & 7) * 8; ld_taps(H + (size_t)(tb + l) * HP + C_XBC + head * 64 + g8, tb + l, Rx); Rz = *(const u32x4*)(H + (size_t)(tb + l) * HP + C_Z + head * 64 + g8); }
#pragma unroll
        for (int i = 0; i < 2; ++i) { const int it = tid + 512 * i, l = it >> 4, g8 = (it & 15) * 8;
          ld_taps(H + (size_t)(tb + l) * HP + C_XBC + 1024 + grp * 128 + g8, tb + l, RB[i]); ld_taps(H + (size_t)(tb + l) * HP + C_XBC + 1280 + grp * 128 + g8, tb + l, RC[i]); }
    };
    ssd_load(0);
    __syncthreads();
#pragma unroll 1
    for (int c = 0; c < SEQ / 64; ++c) {
        const int t0 = c * 64;
        if (wid == 0) { const float dt = dts[t0 + lane]; float a = dt * A;
#pragma unroll
            for (int o = 1; o < 64; o <<= 1) { const float t = __shfl_up(a, o); a += (lane >= o) ? t : 0.f; }
            acs[lane] = a; dtv[lane] = dt; }
        __syncthreads();
        const float aend = acs[63];
        { const int l = tid >> 3, g8 = (tid & 7) * 8; float v[8]; const float wl = __expf(aend - acs[l]) * dtv[l];
          conv8_regs(Rx, wt, 320, g8, true, v);
#pragma unroll
          for (int j = 0; j < 8; ++j) { XT[(g8 + j) * PL + l] = f2bf(v[j]); XwT[(g8 + j) * PL + l] = f2bf(v[j] * wl); }
          unpack8(Rz, v); st8(zs + l * 64 + g8, v); }
#pragma unroll
        for (int i = 0; i < 2; ++i) { const int it = tid + 512 * i, l = it >> 4, g8 = (it & 15) * 8; float v[8];
          conv8_regs(RB[i], wt, 320, 64 + g8, true, v); *(LAS u32x4*)(Bm + l * PN + g8) = pack8(v);
#pragma unroll
          for (int j = 0; j < 8; ++j) BmT[(g8 + j) * PL + l] = f2bf(v[j]);
          conv8_regs(RC[i], wt, 320, 192 + g8, true, v); *(LAS u32x4*)(Cm + l * PN + g8) = pack8(v); }
        __syncthreads();
        if (c + 1 < SEQ / 64) ssd_load(t0 + 64);
        { const int mt = wid >> 1;
#pragma unroll
          for (int n2 = 0; n2 < 2; ++n2) { const int nt = (wid & 1) * 2 + n2; f32x4 acc = {0.f, 0.f, 0.f, 0.f};
            if (nt <= mt) acc = mm16<128>(Cm + 16 * mt * PN, PN, Bm + 16 * nt * PN, PN, acc, fr, fq);
            const int s = 16 * nt + fr; const float as = acs[s], ds = dtv[s];
#pragma unroll
            for (int j = 0; j < 4; ++j) { const int l = 16 * mt + 4 * fq + j; WM[l * PL + s] = f2bf(s <= l ? acc[j] * __expf(acs[l] - as) * ds : 0.f); } } }
        __syncthreads();
        { const int mt = wid >> 1;
#pragma unroll
          for (int n2 = 0; n2 < 2; ++n2) { const int nt = (wid & 1) * 2 + n2; f32x4 ai = {0.f, 0.f, 0.f, 0.f}, ae = {0.f, 0.f, 0.f, 0.f};
            ai = mm16<64>(WM + 16 * mt * PL, PL, XT + 16 * nt * PL, PL, ai, fr, fq);
            ae = mm16<128>(Cm + 16 * mt * PN, PN, SL + 16 * nt * PN, PN, ae, fr, fq);
            const int pc = 16 * nt + fr;
#pragma unroll
            for (int j = 0; j < 4; ++j) { const int l = 16 * mt + 4 * fq + j; const float xv = bf2f(XT[pc * PL + l]);
                const float y = ai[j] + __expf(acs[l]) * ae[j] + Dk * xv; const float o = y * siluf_(zs[l * 64 + pc]);
                if (!dry) H[(size_t)(t0 + l) * HP + C_Z + head * 64 + pc] = f2bf(o); } } }
        { const int pt = wid & 3, ntb = (wid >> 2) * 4; const float ea = __expf(aend);
#pragma unroll
          for (int n4 = 0; n4 < 4; ++n4) { Sacc[n4] = Sacc[n4] * ea; Sacc[n4] = mm16<64>(XwT + 16 * pt * PL, PL, BmT + 16 * (ntb + n4) * PL, PL, Sacc[n4], fr, fq); } }
        __syncthreads();
        { const int pt = wid & 3, ntb = (wid >> 2) * 4;
#pragma unroll
          for (int n4 = 0; n4 < 4; ++n4)
#pragma unroll
            for (int j = 0; j < 4; ++j) SL[(16 * pt + 4 * fq + j) * PN + 16 * (ntb + n4) + fr] = f2bf(Sacc[n4][j]); }
    }
}
__device__ __forceinline__ void gdn_chunked(const Params& p, int layer, int idx, LAS unsigned char* lds, bool dry) {
    const int tid = tid_(), lane = tid & 63, wid = tid >> 6, fr = lane & 15, fq = lane >> 4, bh = idx >> 1, vh = idx & 1, b = bh >> 2, hh = bh & 3;
    const bf16_t* H = (const bf16_t*)(p.ws + WS_BIG) + (size_t)b * SEQ * HP; const float* hs = (const float*)(p.ws + WS_HS) + (size_t)b * SEQ * HS;
    bf16_t* GO = (bf16_t*)(p.ws + WS_GO) + (size_t)b * SEQ * 512;
    constexpr int PD = 136, PL = 72;
    LAS float* gs  = (LAS float*)lds;
    LAS float* bts = gs + 2048;
    LAS float* wt  = bts + 2048;
    LAS float* gcs = wt + 1280;
    LAS float* bet = gcs + 64;
    LAS float* Ap  = bet + 64;
    LAS float* Rb  = Ap + 64 * 64;
    LAS bf16_t* Kn  = (LAS bf16_t*)(Rb + 64 * 64);
    LAS bf16_t* Qn  = Kn + 64 * PD;
    LAS bf16_t* ST  = Qn + 64 * PD;
    LAS bf16_t* KdT = ST + 64 * PD;
    LAS bf16_t* VnT = KdT + 128 * PL;
    LAS bf16_t* AT  = VnT + 64 * PL;
    const float An = -__expf(p.in[9][layer * 4 + hh]), dtb = p.in[10][layer * 4 + hh];
    for (int t = tid; t < SEQ; t += 512) { gs[t] = An * softplusf_(hs[(size_t)t * HS + 16 + hh] + dtb); bts[t] = sigmoidf_(hs[(size_t)t * HS + 20 + hh]); }
    if (tid < 320) { const int ch = tid < 128 ? hh * 128 + tid : (tid < 256 ? 512 + hh * 128 + (tid - 128) : 1024 + hh * 128 + vh * 64 + (tid - 256));
        const float* cw = p.in[8] + (size_t)layer * 4 * 1536;
#pragma unroll
        for (int k = 0; k < 4; ++k) wt[k * 320 + tid] = cw[k * 1536 + ch]; }
    for (int i = tid; i < 64 * PD; i += 512) ST[i] = (bf16_t)0;
    f32x4 Sacc[4];
#pragma unroll
    for (int j = 0; j < 4; ++j) Sacc[j] = (f32x4){0.f, 0.f, 0.f, 0.f};
    Raw4 Rq[2], Rk[2], Rv;
    auto gdn_load = [&](int tb) {
#pragma unroll
        for (int i = 0; i < 2; ++i) { const int it = tid + 512 * i, l = it >> 4, g8 = (it & 15) * 8;
          ld_taps(H + (size_t)(tb + l) * HP + C_GQKV + hh * 128 + g8, tb + l, Rq[i]); ld_taps(H + (size_t)(tb + l) * HP + C_GQKV + 512 + hh * 128 + g8, tb + l, Rk[i]); }
        { const int l = tid >> 3, g8 = (tid & 7) * 8; ld_taps(H + (size_t)(tb + l) * HP + C_GQKV + 1024 + hh * 128 + vh * 64 + g8, tb + l, Rv); }
    };
    gdn_load(0);
    __syncthreads();
#pragma unroll 1
    for (int c = 0; c < SEQ / 64; ++c) {
        const int t0 = c * 64;
        if (wid == 0) { float a = gs[t0 + lane];
#pragma unroll
            for (int o = 1; o < 64; o <<= 1) { const float t = __shfl_up(a, o); a += (lane >= o) ? t : 0.f; }
            gcs[lane] = a; bet[lane] = bts[t0 + lane]; }
        __syncthreads();
        const float gend = gcs[63];
#pragma unroll
        for (int i = 0; i < 2; ++i) { const int it = tid + 512 * i, l = it >> 4, g8 = (it & 15) * 8; float v[8]; float sq = 0.f;
          conv8_regs(Rq[i], wt, 320, g8, false, v);
#pragma unroll
          for (int j = 0; j < 8; ++j) sq += v[j] * v[j];
          sq = rsqrtf(red16(sq) + RMS_EPS) * 0.08838834764831845f;
#pragma unroll
          for (int j = 0; j < 8; ++j) v[j] *= sq;
          *(LAS u32x4*)(Qn + l * PD + g8) = pack8(v); sq = 0.f;
          conv8_regs(Rk[i], wt, 320, 128 + g8, false, v);
#pragma unroll
          for (int j = 0; j < 8; ++j) sq += v[j] * v[j];
          sq = rsqrtf(red16(sq) + RMS_EPS);
#pragma unroll
          for (int j = 0; j < 8; ++j) v[j] *= sq;
          *(LAS u32x4*)(Kn + l * PD + g8) = pack8(v);
          const float de = __expf(gend - gcs[l]);
#pragma unroll
          for (int j = 0; j < 8; ++j) KdT[(g8 + j) * PL + l] = f2bf(v[j] * de); }
        { const int l = tid >> 3, g8 = (tid & 7) * 8; float v[8]; conv8_regs(Rv, wt, 320, 256 + g8, false, v); st8(Rb + l * 64 + g8, v); }
        __syncthreads();
        if (c + 1 < SEQ / 64) gdn_load(t0 + 64);
        { const int mt = wid >> 1;
#pragma unroll
          for (int n2 = 0; n2 < 2; ++n2) { const int nt = (wid & 1) * 2 + n2; f32x4 akk = {0.f, 0.f, 0.f, 0.f}, aqk = {0.f, 0.f, 0.f, 0.f};
            if (nt <= mt) { akk = mm16<128>(Kn + 16 * mt * PD, PD, Kn + 16 * nt * PD, PD, akk, fr, fq); aqk = mm16<128>(Qn + 16 * mt * PD, PD, Kn + 16 * nt * PD, PD, aqk, fr, fq); }
            const int s = 16 * nt + fr; const float gss = gcs[s];
#pragma unroll
            for (int j = 0; j < 4; ++j) { const int l = 16 * mt + 4 * fq + j; const float dec = s <= l ? __expf(gcs[l] - gss) : 0.f;
                Ap[l * 64 + (s & 7) * 8 + (s >> 3)] = s < l ? bet[l] * akk[j] * dec : 0.f; AT[l * PL + s] = f2bf(aqk[j] * dec); } } }
        { const int mt = wid >> 1;
#pragma unroll
          for (int n2 = 0; n2 < 2; ++n2) { const int nt = (wid & 1) * 2 + n2; f32x4 acc = {0.f, 0.f, 0.f, 0.f};
            acc = mm16<128>(Kn + 16 * mt * PD, PD, ST + 16 * nt * PD, PD, acc, fr, fq);
#pragma unroll
            for (int j = 0; j < 4; ++j) { const int l = 16 * mt + 4 * fq + j, vc = 16 * nt + fr; Rb[l * 64 + vc] = bet[l] * (Rb[l * 64 + vc] - __expf(gcs[l]) * acc[j]); } } }
        __syncthreads();
        { const int col = tid >> 3, part = tid & 7; float vn[8];
#pragma unroll
          for (int j = 0; j < 8; ++j) vn[j] = 0.f;
#pragma unroll
          for (int i = 0; i < 64; ++i) { const float r = Rb[i * 64 + col]; float ps = 0.f; const int nj = (i + 7) >> 3;
              if (nj > 0) { const f32x4 a0 = *(const LAS f32x4*)(Ap + i * 64 + part * 8);
#pragma unroll
                  for (int jj = 0; jj < 4; ++jj) if (jj < nj) ps += a0[jj] * vn[jj]; }
              if (nj > 4) { const f32x4 a1 = *(const LAS f32x4*)(Ap + i * 64 + part * 8 + 4);
#pragma unroll
                  for (int jj = 0; jj < 4; ++jj) if (jj + 4 < nj) ps += a1[jj] * vn[4 + jj]; }
              const float x = r - red8(ps);
              vn[i >> 3] = (part == (i & 7)) ? x : vn[i >> 3]; }
#pragma unroll
          for (int jj = 0; jj < 8; ++jj) VnT[col * PL + 8 * jj + part] = f2bf(vn[jj]); }
        __syncthreads();
        { const int mt = wid >> 1;
#pragma unroll
          for (int n2 = 0; n2 < 2; ++n2) { const int nt = (wid & 1) * 2 + n2; f32x4 ae = {0.f, 0.f, 0.f, 0.f}, ai = {0.f, 0.f, 0.f, 0.f};
            ae = mm16<128>(Qn + 16 * mt * PD, PD, ST + 16 * nt * PD, PD, ae, fr, fq);
            ai = mm16<64>(AT + 16 * mt * PL, PL, VnT + 16 * nt * PL, PL, ai, fr, fq);
            if (!dry) {
#pragma unroll
                for (int j = 0; j < 4; ++j) { const int l = 16 * mt + 4 * fq + j; GO[(size_t)(t0 + l) * 512 + hh * 128 + vh * 64 + 16 * nt + fr] = f2bf(__expf(gcs[l]) * ae[j] + ai[j]); } } } }
        { const int vt = wid & 3, db = (wid >> 2) * 4; const float eg = __expf(gend);
#pragma unroll
          for (int d4 = 0; d4 < 4; ++d4) { Sacc[d4] = Sacc[d4] * eg; Sacc[d4] = mm16<64>(VnT + 16 * vt * PL, PL, KdT + 16 * (db + d4) * PL, PL, Sacc[d4], fr, fq); } }
        __syncthreads();
        { const int vt = wid & 3, db = (wid >> 2) * 4;
#pragma unroll
          for (int d4 = 0; d4 < 4; ++d4)
#pragma unroll
            for (int j = 0; j < 4; ++j) ST[(16 * vt + 4 * fq + j) * PD + 16 * (db + d4) + fr] = f2bf(Sacc[d4][j]); }
    }
}
__device__ __forceinline__ void phase_mixers(const Params& p, int layer, LAS unsigned char* lds, bool dry) {
    for (int role = blockIdx.x; role < 224; role += gridDim.x) {
        __syncthreads();
        if (role < 64) gdn_chunked(p, layer, role, lds, dry);
        else if (role < 96) gla_chunked(p, layer, role - 64, lds, dry);
        else ssd_chunked(p, layer, role - 96, lds, dry);
    }
}
__device__ __forceinline__ void phase_finalize(const Params& p, int layer) {
    const int tid = tid_(), wid = tid >> 6, lane = tid & 63;
    bf16_t* H = (bf16_t*)(p.ws + WS_BIG);
    float nws[2][8], nwg[8], nwl[8];
#pragma unroll
    for (int j = 0; j < 8; ++j) { nws[0][j] = p.in[7][layer * 1024 + 8 * lane + j]; nws[1][j] = p.in[7][layer * 1024 + 512 + 8 * lane + j]; nwg[j] = p.in[11][layer * 128 + ((8 * lane + j) & 127)]; nwl[j] = p.in[14][layer * 128 + ((8 * lane + j) & 127)]; }
    for (int tok = blockIdx.x * 8 + wid; tok < MTOK; tok += gridDim.x * 8) {
        bf16_t* row = H + (size_t)tok * HP;
#pragma unroll
        for (int g = 0; g < 2; ++g) { float v[8]; unpack8(*(const u32x4*)(row + C_Z + 512 * g + 8 * lane), v); float s = 0.f;
#pragma unroll
            for (int j = 0; j < 8; ++j) s += v[j] * v[j];
#pragma unroll
            for (int o = 1; o < 64; o <<= 1) s += __shfl_xor(s, o);
            const float rs = rsqrtf(s * (1.f / 512.f) + RMS_EPS);
#pragma unroll
            for (int j = 0; j < 8; ++j) v[j] = v[j] * rs * nws[g][j];
            *(u32x4*)(row + C_Z + 512 * g + 8 * lane) = pack8(v); }
#pragma unroll
        for (int br = 0; br < 2; ++br) { const int craw = br == 0 ? C_GQKV : C_LQKV + 512, cgt = br == 0 ? C_GG : C_LR;
            float v[8], gt[8]; unpack8(br == 0 ? *(const u32x4*)((const bf16_t*)(p.ws + WS_GO) + (size_t)tok * 512 + 8 * lane) : *(const u32x4*)(row + craw + 8 * lane), v); unpack8(*(const u32x4*)(row + cgt + 8 * lane), gt); float s = 0.f;
#pragma unroll
            for (int j = 0; j < 8; ++j) s += v[j] * v[j];
#pragma unroll
            for (int o = 1; o < 16; o <<= 1) s += __shfl_xor(s, o);
            const float rs = rsqrtf(s * (1.f / 128.f) + RMS_EPS);
#pragma unroll
            for (int j = 0; j < 8; ++j) v[j] = v[j] * rs * (br == 0 ? nwg[j] : nwl[j]) * siluf_(gt[j]);
            *(u32x4*)(row + cgt + 8 * lane) = pack8(v); }
    }
}
__device__ __forceinline__ void phase_ln(const Params& p, const float* gam, const float* bet) {
    const int tid = tid_(), wid = tid >> 6, lane = tid & 63;
    float* X = p.out; bf16_t* xb = (bf16_t*)(p.ws + WS_XB);
    f32x4 gv[4], bv[4];
#pragma unroll
    for (int j = 0; j < 4; ++j) { gv[j] = *(const f32x4*)(gam + 256 * j + 4 * lane); bv[j] = *(const f32x4*)(bet + 256 * j + 4 * lane); }
    for (int row = blockIdx.x * 8 + wid; row < MTOK; row += gridDim.x * 8) {
        float* xr = X + (size_t)row * DM; f32x4 v[4]; float s = 0.f;
#pragma unroll
        for (int j = 0; j < 4; ++j) { v[j] = *(const f32x4*)(xr + 256 * j + 4 * lane); s += (v[j][0] + v[j][1]) + (v[j][2] + v[j][3]); }
#pragma unroll
        for (int o = 1; o < 64; o <<= 1) s += __shfl_xor(s, o);
        const float mean = s * (1.f / DM); float q = 0.f;
#pragma unroll
        for (int j = 0; j < 4; ++j) { v[j] = v[j] - mean; q += (v[j][0] * v[j][0] + v[j][1] * v[j][1]) + (v[j][2] * v[j][2] + v[j][3] * v[j][3]); }
#pragma unroll
        for (int o = 1; o < 64; o <<= 1) q += __shfl_xor(q, o);
        const float rstd = rsqrtf(q * (1.f / DM) + LN_EPS);
#pragma unroll
        for (int j = 0; j < 4; ++j) { const f32x4 o = v[j] * rstd * gv[j] + bv[j]; *(f32x4*)(xr + 256 * j + 4 * lane) = o;
            uint2 w; w.x = pk2(o[0], o[1]); w.y = pk2(o[2], o[3]); *(uint2*)(xb + (size_t)row * DM + 256 * j + 4 * lane) = w; }
    }
}
__device__ __forceinline__ void phase_convglu(const Params& p, int layer) {
    const int tid = tid_(), seg = tid >> 4, il = tid & 15;
    bf16_t* U = (bf16_t*)(p.ws + WS_BIG);
    const float* cw = p.in[22] + (size_t)layer * 3 * FF2; const float* cbp = p.in[23] + (size_t)layer * FF2;
    for (int w = blockIdx.x; w < NB * 22; w += gridDim.x) {
        const int b = w / 22, cgp = (w % 22) * 16 + il, c0 = cgp * 8;
        float wg[3][8], wu[3][8], bg[8], bu[8];
#pragma unroll
        for (int j = 0; j < 8; ++j) { bg[j] = cbp[c0 + j]; bu[j] = cbp[FF + c0 + j];
#pragma unroll
            for (int k = 0; k < 3; ++k) { wg[k][j] = cw[k * FF2 + c0 + j]; wu[k][j] = cw[k * FF2 + FF + c0 + j]; } }
        bf16_t* base = U + ((size_t)b * SEQ + seg * 64) * FF2 + c0;
        float g2[8], g1[8], u2[8], u1[8];
        if (seg > 0) { unpack8(*(const u32x4*)(base - 2 * (size_t)FF2), g2); unpack8(*(const u32x4*)(base - (size_t)FF2), g1); unpack8(*(const u32x4*)(base - 2 * (size_t)FF2 + FF), u2); unpack8(*(const u32x4*)(base - (size_t)FF2 + FF), u1); }
        else {
#pragma unroll
            for (int j = 0; j < 8; ++j) { g2[j] = 0.f; g1[j] = 0.f; u2[j] = 0.f; u1[j] = 0.f; } }
        __syncthreads();
#pragma unroll 4
        for (int r = 0; r < 64; ++r) { bf16_t* rp = base + (size_t)r * FF2; float gc[8], uc[8], o[8]; unpack8(*(const u32x4*)rp, gc); unpack8(*(const u32x4*)(rp + FF), uc);
#pragma unroll
            for (int j = 0; j < 8; ++j) { const float gg = wg[0][j] * g2[j] + wg[1][j] * g1[j] + wg[2][j] * gc[j] + bg[j], uu = wu[0][j] * u2[j] + wu[1][j] * u1[j] + wu[2][j] * uc[j] + bu[j];
                o[j] = siluf_(gg) * uu; g2[j] = g1[j]; g1[j] = gc[j]; u2[j] = u1[j]; u1[j] = uc[j]; }
            *(u32x4*)rp = pack8(o); }
        __syncthreads();
    }
}

#define XB_TMO      128
#define XB_XCNT(j)  (256  + 64 * (j))
#define XB_XSUB(j)  (1280 + 64 * (j))
#define XB_XGEN(j)  (2304 + 64 * (j))
#define XB_TOP      3328
#define XB_TOPGEN   3392
#define XCD_BAR_WORDS 3456
#define XB_SPIN_CAP (1u << 18)

__device__ __forceinline__ unsigned xb_ld(unsigned* p)              { return __hip_atomic_load(p, __ATOMIC_RELAXED, __HIP_MEMORY_SCOPE_AGENT); }
__device__ __forceinline__ unsigned xb_add(unsigned* p, unsigned v) { return __hip_atomic_fetch_add(p, v, __ATOMIC_RELAXED, __HIP_MEMORY_SCOPE_AGENT); }
__device__ __forceinline__ unsigned xb_xcc_id() { return (unsigned)__builtin_amdgcn_s_getreg((3 << 11) | 20) & 0xFu; }
#define XB_SPIN(cond, bar) do { unsigned _sp = 0; while (cond) { __builtin_amdgcn_s_sleep(1); \
    if ((++_sp & 255u) == 0u) { if (xb_ld(&(bar)[XB_TMO])) break; if (_sp > XB_SPIN_CAP) { atomicAdd(&(bar)[XB_TMO], 1u); break; } } } } while (0)

struct XcdBarrier {
    unsigned* bar; unsigned x;
    volatile LAS unsigned* st;
};

__device__ __forceinline__ XcdBarrier xcd_barrier_post(unsigned* bar, volatile LAS unsigned* st) {
    XcdBarrier b; b.bar = bar; b.x = xb_xcc_id(); b.st = st;
    if (threadIdx.x == 0) st[2] = xb_add(&bar[XB_XCNT(b.x)], 1u);
    return b;
}
__device__ __forceinline__ void xcd_barrier_complete(unsigned* bar, unsigned x, unsigned& nloc, unsigned& nx) {
    const unsigned G = gridDim.x * gridDim.y * gridDim.z;
    unsigned sum, cnt, mine, sp = 0u;
    for (;;) {
        sum = 0u; cnt = 0u; mine = 0u;
#pragma unroll
        for (unsigned j = 0; j < 16; ++j) { const unsigned c = xb_ld(&bar[XB_XCNT(j)]); sum += c; cnt += (c > 0u) ? 1u : 0u; mine = (j == x) ? c : mine; }
        if (sum == G) break;
        __builtin_amdgcn_s_sleep(1);
        if ((++sp & 255u) == 0u) { if (xb_ld(&bar[XB_TMO])) break; if (sp > XB_SPIN_CAP) { atomicAdd(&bar[XB_TMO], 1u); break; } }
    }
    nloc = mine > 0u ? mine : 1u; nx = cnt > 0u ? cnt : 1u;
}

__device__ __forceinline__ void xcd_barrier(const XcdBarrier& b) {
    asm volatile("s_waitcnt vmcnt(0)" ::: "memory");
    __syncthreads();
    if (threadIdx.x == 0) {
        unsigned* bar = b.bar;
        __builtin_amdgcn_s_waitcnt(0);
        unsigned nloc = b.st[0], nx = b.st[1];
        if (nloc == 0u) { xcd_barrier_complete(bar, b.x, nloc, nx); b.st[0] = nloc; b.st[1] = nx; }
        const unsigned old = xb_add(&bar[XB_XSUB(b.x)], 1u);
        const unsigned gen = old / nloc;
        if (old + 1u == (gen + 1u) * nloc) {
            __builtin_amdgcn_fence(__ATOMIC_RELEASE, "agent");
            asm volatile("s_waitcnt vmcnt(0)" ::: "memory");
            const unsigned og = xb_add(&bar[XB_TOP], 1u);
            const unsigned tg = og / nx;
            if (og + 1u == (tg + 1u) * nx) xb_add(&bar[XB_TOPGEN], 1u);
            else XB_SPIN(xb_ld(&bar[XB_TOPGEN]) == tg, bar);
            __builtin_amdgcn_fence(__ATOMIC_ACQUIRE, "agent");
            xb_add(&bar[XB_XGEN(b.x)], 1u);
            asm volatile("s_waitcnt vmcnt(0)" ::: "memory");
        } else {
            XB_SPIN(xb_ld(&bar[XB_XGEN(b.x)]) == gen, bar);
            __builtin_amdgcn_fence(__ATOMIC_ACQUIRE, "agent");
            asm volatile("s_waitcnt vmcnt(0)" ::: "memory");
        }
    }
    __syncthreads();
}


#ifndef ONLY
#define ONLY -1
#endif
#ifndef PROBE_SYNC
#define PROBE_SYNC 0
#endif
#ifndef PROBE_GEMM
#define PROBE_GEMM 0
#endif
#ifndef PROBE_SYNC
#define PROBE_SYNC 0
#endif
#ifndef PROBE_GEMM
#define PROBE_GEMM 0
#endif
#ifndef PROBE_MIX
#define PROBE_MIX 0
#endif
#ifndef DBG_SKIP
#define DBG_SKIP 0
#endif
#ifndef PHMASK
#define PHMASK 0xFFFF
#endif
#define PH(n) ((ONLY < 0 || ONLY == (n)) && ((PHMASK >> (n)) & 1))
__global__ void __launch_bounds__(512) mega_fwd(Params p) {
    extern __shared__ __attribute__((aligned(16))) unsigned char shm[];
    LAS unsigned char* lds = (LAS unsigned char*)shm;
    cg::grid_group grid = cg::this_grid();
    unsigned char* ws = p.ws;
    bf16_t* XB = (bf16_t*)(ws + WS_XB); bf16_t* H = (bf16_t*)(ws + WS_BIG);
    const bf16_t* W1 = (const bf16_t*)(ws + W_W1); const bf16_t* WG = (const bf16_t*)(ws + W_G);
    volatile LAS unsigned* xst = (volatile LAS unsigned*)(lds + LDS_BYTES - 16);
    if (threadIdx.x == 0) { xst[0] = 0u; xst[1] = 0u; xst[2] = 0u; xst[3] = blockIdx.x; }
    __syncthreads();
    const XcdBarrier xb = xcd_barrier_post((unsigned*)(ws + WS_BAR), xst);
    bf16_t* SG = H + C_XBC; bf16_t* MX = H + C_GQKV;
#if PROBE_SYNC
#pragma unroll 1
    for (int i = 0; i < 40; ++i) grid.sync();
#endif
#pragma unroll 1
    for (int layer = 0; layer < DEPTH; ++layer) {
#pragma unroll 1
        for (int st = 0; st < 16; ++st) {
            GJob j; bool isg = false, sync = true;
            j.A = XB; j.lda = DM; j.Bt = W1; j.ldb = DM; j.N = DM; j.K = DM; j.E.mode = 0; j.E.O = H; j.E.ldc = HP; j.E.Sg = SG; j.E.base = p.out; j.E.out = p.out;
            switch (st) {
            case 0: if (PH(0)) { phase_convert(p, layer, lds); if (layer == 0) phase_x_to_bf16(p); } break;
            case 1: isg = true; j.N = HP; break;
            case 2: if (PH(3)) {
#if PROBE_MIX
                phase_mixers(p, layer, lds, p.ws != nullptr); xcd_barrier(xb);
#endif
                phase_mixers(p, layer, lds, p.ws == nullptr); } break;
            case 3: if (PH(4)) phase_finalize(p, layer); break;
            case 4: isg = true; sync = false; j.Bt = WG; j.E.mode = 1; j.E.O = SG; break;
            case 5: isg = true; sync = false; j.A = H + C_Z; j.lda = HP; j.Bt = (const bf16_t*)(ws + W_PS); j.ldb = 1024; j.K = 1024; j.E.mode = 2; j.E.O = MX; break;
            case 6: isg = true; sync = false; j.Bt = WG + (size_t)1024 * 1024; j.E.mode = 1; j.E.O = SG; break;
            case 7: isg = true; sync = false; j.A = H + C_GG; j.lda = HP; j.Bt = (const bf16_t*)(ws + W_PG); j.ldb = 512; j.K = 512; j.E.mode = 3; j.E.O = MX; break;
            case 8: isg = true; sync = false; j.Bt = WG + (size_t)2048 * 1024; j.E.mode = 1; j.E.O = SG; break;
            case 9: isg = true; j.A = H + C_LR; j.lda = HP; j.Bt = (const bf16_t*)(ws + W_PL); j.ldb = 512; j.K = 512; j.E.mode = 3; j.E.O = MX; break;
            case 10: isg = true; j.A = MX; j.lda = HP; j.Bt = (const bf16_t*)(ws + W_O); j.E.mode = 4; j.E.base = layer == 0 ? p.in[0] : p.out; break;
            case 11: if (PH(7)) phase_ln(p, p.in[19] + layer * DM, p.in[20] + layer * DM); break;
            case 12: isg = true; j.Bt = (const bf16_t*)(ws + W_UP); j.N = FF2; j.E.ldc = FF2; break;
            case 13: if (PH(9)) phase_convglu(p, layer); break;
            case 14: isg = true; j.A = H; j.lda = FF2; j.Bt = (const bf16_t*)(ws + W_DN); j.ldb = FF; j.K = FF; j.E.mode = 4; break;
            default: if (PH(7)) phase_ln(p, p.in[25] + layer * DM, p.in[26] + layer * DM); break;
            }
            if ((DBG_SKIP & 1) && (st == 4 || st == 5)) isg = false;
            if ((DBG_SKIP & 2) && (st == 6 || st == 7)) isg = false;
            if ((DBG_SKIP & 4) && (st == 8 || st == 9)) isg = false;
            if (DBG_SKIP == 7 && st == 9) { isg = true; j.E.mode = 5; j.E.O = MX; }
            if ((DBG_SKIP & 1) && st == 7) j.E.mode = 2;
            if ((DBG_SKIP & 3) == 3 && st == 9) j.E.mode = 2;
            if (PH(1) && isg) run_gemm(lds, j, (int)xst[3]);
#if PROBE_GEMM
            if (isg && (st == 1 || st == 12)) { xcd_barrier(xb); run_gemm(lds, j, (int)xst[3]); }
#endif
#if PROBE_GEMM
            if (isg && (st == 1 || st == 12)) { xcd_barrier(xb); run_gemm(lds, j, (int)xst[3]); }
#endif
            if (st == 1 && PH(2)) phase_small(p);
            if (sync) { if (layer == 0 && st == 0) { grid.sync();
                    if (threadIdx.x == 0) {
                        bool ok = (gridDim.x & 7u) == 0u;
                        for (unsigned jx = 0; jx < 8; ++jx) ok = ok && (xb_ld(&xb.bar[XB_XCNT(jx)]) == gridDim.x / 8u);
                        xst[3] = (ok && xb.x < 8u) ? xst[2] * 8u + xb.x : blockIdx.x; }
                    __syncthreads(); }
                else xcd_barrier(xb); }
        }
    }
}

extern "C" void kernel_launch(void* const* d_in, const int* in_sizes, int n_in, void* d_out, int out_size, void* d_ws, size_t ws_size, hipStream_t stream) {
    static int grid_blocks = 0;
    if (grid_blocks == 0) {
        if (n_in != 27 || out_size != MTOK * DM || ws_size < WS_END) { fprintf(stderr, "kernel_launch: unexpected shapes (n_in %d out %d ws %zu need %zu)\n", n_in, out_size, ws_size, (size_t)WS_END); grid_blocks = -1; return; }
        int dev = 0, cus = 0, per_cu = 0;
        (void)hipGetDevice(&dev); (void)hipDeviceGetAttribute(&cus, hipDeviceAttributeMultiprocessorCount, dev);
        if (hipFuncSetAttribute((const void*)mega_fwd, hipFuncAttributeMaxDynamicSharedMemorySize, LDS_BYTES) != hipSuccess) { fprintf(stderr, "kernel_launch: hipFuncSetAttribute failed\n"); grid_blocks = -1; return; }
        if (hipOccupancyMaxActiveBlocksPerMultiprocessor(&per_cu, (const void*)mega_fwd, 512, LDS_BYTES) != hipSuccess || per_cu < 1) { fprintf(stderr, "kernel_launch: occupancy query failed (%d)\n", per_cu); grid_blocks = -1; return; }
        grid_blocks = cus * per_cu; if (grid_blocks > 256) grid_blocks = 256;
        fprintf(stderr, "kernel_launch: %d CUs x %d -> grid %d\n", cus, per_cu, grid_blocks);
    }
    if (grid_blocks < 0) return;
    if (hipMemsetAsync((unsigned char*)d_ws + WS_BAR, 0, XCD_BAR_WORDS * sizeof(unsigned), stream) != hipSuccess) { fprintf(stderr, "kernel_launch: memset of barrier words failed\n"); return; }
    Params p{};
    for (int i = 0; i < 27; ++i) p.in[i] = (const float*)d_in[i];
    p.out = (float*)d_out; p.ws = (unsigned char*)d_ws;
    void* args[] = {&p};
    hipError_t e = hipLaunchCooperativeKernel((const void*)mega_fwd, dim3(grid_blocks), dim3(512), args, LDS_BYTES, stream);
    if (e != hipSuccess) fprintf(stderr, "kernel_launch: cooperative launch failed: %s (grid %d)\n", hipGetErrorString(e), grid_blocks);
}
```
